# Optimizing an MI355X kernel written in HIP

```python
import math
import jax, jax.numpy as jnp
from jax import lax
import numpy as np

D_MODEL = 1024
BATCH = 4
SEQ = 8192
DEPTH = 1

PLE_DIM = 256
HG_HEADS = 8
HG_KEY = 128
HG_VAL = 128
HG_KWIDTH = HG_HEADS * HG_KEY
HG_WIDTH = HG_HEADS * HG_VAL
HG_CHUNK = 64
S5_GROUP = 16
S5_WIDTH = 512
S5_GROUPS = S5_WIDTH // S5_GROUP
S5_STATE = 64
DT_MIN = 0.001
DT_MAX = 0.1
NORM_EPS = 1e-6
IN_SIZES = (HG_KWIDTH, HG_KWIDTH, HG_WIDTH, HG_WIDTH, S5_WIDTH, S5_WIDTH, D_MODEL, D_MODEL)
IN_COLS = HG_KWIDTH * 2 + HG_WIDTH * 2 + S5_WIDTH * 2 + D_MODEL * 2

kernel_name = "hybrid_hgrn2_s5_gated_block"


def _split_points():
    pts, acc = [], 0
    for s in IN_SIZES[:-1]:
        acc += s
        pts.append(acc)
    return pts


def rms_norm(x, g):
    xf = x.astype(jnp.float32)
    y = xf * lax.rsqrt(jnp.mean(xf * xf, axis=-1, keepdims=True) + NORM_EPS)
    return (y * g.astype(jnp.float32)).astype(x.dtype)


def hgrn2_mix(q, f_logit, iv, lb):
    f32 = jnp.float32
    bsz, seq = q.shape[0], q.shape[1]
    nc = seq // HG_CHUNK
    lb = lb.reshape(HG_HEADS, HG_KEY).astype(f32)
    sig = jax.nn.sigmoid(f_logit.astype(f32))
    log_f = jnp.log(lb + (1.0 - lb) * sig)
    k = (1.0 - lb) * (1.0 - sig)
    chunk = lambda t: t.astype(f32).reshape(bsz, nc, HG_CHUNK, HG_HEADS, t.shape[-1])
    q, k, iv, log_f = chunk(q), chunk(k), chunk(iv), chunk(log_f)
    b = jnp.cumsum(log_f, axis=2)
    b_mid = b[:, :, HG_CHUNK // 2 - 1:HG_CHUNK // 2]
    b_last = b[:, :, HG_CHUNK - 1:HG_CHUNK]
    scores = jnp.einsum('bnthk,bnshk->bnhts', q * jnp.exp(b - b_mid), k * jnp.exp(b_mid - b))
    causal = jnp.tril(jnp.ones((HG_CHUNK, HG_CHUNK), dtype=bool))
    scores = jnp.where(causal, scores, 0.0)
    o_intra = jnp.einsum('bnhts,bnshv->bnthv', scores, iv)
    q_dec = q * jnp.exp(b)
    k_dec = k * jnp.exp(b_last - b)
    chunk_decay = jnp.exp(b_last[:, :, 0])

    def step(state, xs):
        qc, kc, ic, dc = xs
        o = jnp.einsum('bthk,bhkv->bthv', qc, state)
        state = dc[..., None] * state + jnp.einsum('bthk,bthv->bhkv', kc, ic)
        return state, o

    s0 = jnp.zeros((bsz, HG_HEADS, HG_KEY, HG_VAL), f32)
    mv = lambda t: jnp.moveaxis(t, 1, 0)
    _, o_inter = lax.scan(step, s0, (mv(q_dec), mv(k_dec), mv(iv), mv(chunk_decay)))
    o = o_intra + jnp.moveaxis(o_inter, 0, 1)
    return o.reshape(bsz, seq, HG_HEADS, HG_VAL)


def _cmul_combine(e1, e2):
    a1r, a1i, x1r, x1i = e1
    a2r, a2i, x2r, x2i = e2
    return (a1r * a2r - a1i * a2i,
            a1r * a2i + a1i * a2r,
            a2r * x1r - a2i * x1i + x2r,
            a2r * x1i + a2i * x1r + x2i)


def s5_mix(u, a_re, a_im, log_dt, b_re, b_im, c_re, c_im, d):
    f32 = jnp.float32
    uf = u.astype(f32)
    seq = u.shape[1]
    dt = jnp.exp(log_dt.astype(f32))[:, None]
    ar, ai = a_re.astype(f32), a_im.astype(f32)
    mag = jnp.exp(ar * dt)
    lr, li = mag * jnp.cos(ai * dt), mag * jnp.sin(ai * dt)
    den = ar * ar + ai * ai
    nr = lr - 1.0
    sr = (nr * ar + li * ai) / den
    si = (li * ar - nr * ai) / den
    br, bi = b_re.astype(f32), b_im.astype(f32)
    bbr = sr[..., None] * br - si[..., None] * bi
    bbi = sr[..., None] * bi + si[..., None] * br
    xr = jnp.einsum('bsgc,gnc->bsgn', uf, bbr)
    xi = jnp.einsum('bsgc,gnc->bsgn', uf, bbi)
    shape = (1, seq) + lr.shape
    lam_r = jnp.broadcast_to(lr[None, None], shape)
    lam_i = jnp.broadcast_to(li[None, None], shape)
    _, _, hr, hi = lax.associative_scan(_cmul_combine, (lam_r, lam_i, xr, xi), axis=1)
    y = (jnp.einsum('bsgn,gcn->bsgc', hr, c_re.astype(f32))
         - jnp.einsum('bsgn,gcn->bsgc', hi, c_im.astype(f32))
         + d.astype(f32) * uf)
    return y


def setup_inputs(seed: int = 0) -> dict:
    key = jax.random.key(seed)
    ks = jax.random.split(key, 24)
    n = lambda k, shape, scale: jax.random.normal(k, shape, jnp.float32) * scale
    L, G, N, C = DEPTH, S5_GROUPS, S5_STATE, S5_GROUP
    a_im_base = jnp.pi * jnp.arange(N, dtype=jnp.float32)
    return {
        "x": n(ks[0], (BATCH, SEQ, D_MODEL), 1.0),
        "p": n(ks[1], (DEPTH, BATCH, SEQ, PLE_DIM), 1.0),
        "norm_g": 1.0 + n(ks[2], (L, D_MODEL), 0.02),
        "w_in": n(ks[3], (L, D_MODEL, IN_COLS), D_MODEL ** -0.5),
        "hg_lb": n(ks[4], (DEPTH + 1, HG_KWIDTH), 0.1),
        "hg_norm_g": 1.0 + n(ks[5], (L, HG_WIDTH), 0.02),
        "w_o_hg": n(ks[6], (L, HG_WIDTH, D_MODEL), HG_WIDTH ** -0.5),
        "s5_a_re": -0.5 + n(ks[7], (L, G, N), 0.01),
        "s5_a_im": a_im_base[None, None, :] + n(ks[8], (L, G, N), 0.01),
        "s5_log_dt": jax.random.uniform(ks[9], (L, G), jnp.float32, math.log(DT_MIN), math.log(DT_MAX)),
        "s5_b_re": n(ks[10], (L, G, N, C), (2.0 * C) ** -0.5),
        "s5_b_im": n(ks[11], (L, G, N, C), (2.0 * C) ** -0.5),
        "s5_c_re": n(ks[12], (L, G, C, N), N ** -0.5),
        "s5_c_im": n(ks[13], (L, G, C, N), N ** -0.5),
        "s5_d": n(ks[14], (L, G, C), 1.0),
        "w_glu": n(ks[15], (L, S5_WIDTH, 2 * S5_WIDTH), S5_WIDTH ** -0.5),
        "b_glu": n(ks[16], (L, 2 * S5_WIDTH), 0.01),
        "w_o_s5": n(ks[17], (L, S5_WIDTH, D_MODEL), S5_WIDTH ** -0.5),
        "w_out": n(ks[18], (L, D_MODEL, D_MODEL), D_MODEL ** -0.5),
        "ple_norm_g": 1.0 + n(ks[19], (L, D_MODEL), 0.02),
        "w_ple": n(ks[20], (L, PLE_DIM, D_MODEL), PLE_DIM ** -0.5),
        "w_ple_gate": n(ks[21], (L, D_MODEL, D_MODEL), D_MODEL ** -0.5),
        "final_norm_g": 1.0 + n(ks[22], (D_MODEL,), 0.02),
    }


def reference(x, p, norm_g, w_in, hg_lb, hg_norm_g, w_o_hg, s5_a_re, s5_a_im, s5_log_dt,
              s5_b_re, s5_b_im, s5_c_re, s5_c_im, s5_d, w_glu, b_glu, w_o_s5, w_out,
              ple_norm_g, w_ple, w_ple_gate, final_norm_g):
    bsz, seq = x.shape[0], x.shape[1]
    h = x
    lb_all = jnp.cumsum(jax.nn.softmax(hg_lb.astype(jnp.float32), axis=0), axis=0)
    for l in range(DEPTH):
        u = rms_norm(h, norm_g[l])
        proj = u @ w_in[l]
        q, f_logit, iv, g_hg, u_s, z_s, gate_hg, gate_s5 = jnp.split(proj, _split_points(), axis=-1)

        o = hgrn2_mix(q.reshape(bsz, seq, HG_HEADS, HG_KEY),
                      f_logit.reshape(bsz, seq, HG_HEADS, HG_KEY),
                      iv.reshape(bsz, seq, HG_HEADS, HG_VAL), lb_all[l])
        o = rms_norm(o, hg_norm_g[l].reshape(HG_HEADS, HG_VAL)).reshape(bsz, seq, HG_WIDTH)
        y_hg = ((o * jax.nn.silu(g_hg.astype(jnp.float32))).astype(h.dtype) @ w_o_hg[l]).astype(h.dtype)

        ys = s5_mix(u_s.reshape(bsz, seq, S5_GROUPS, S5_GROUP), s5_a_re[l], s5_a_im[l], s5_log_dt[l],
                    s5_b_re[l], s5_b_im[l], s5_c_re[l], s5_c_im[l], s5_d[l]).reshape(bsz, seq, S5_WIDTH)
        ys = jax.nn.gelu(ys).astype(h.dtype)
        glu_a, glu_b = jnp.split(ys @ w_glu[l] + b_glu[l], 2, axis=-1)
        ys = glu_a * jax.nn.sigmoid(glu_b) * jax.nn.silu(z_s)
        y_s5 = (ys @ w_o_s5[l]).astype(h.dtype)

        merged = jax.nn.sigmoid(gate_hg) * y_hg + jax.nn.sigmoid(gate_s5) * y_s5
        h = h + (merged @ w_out[l]).astype(h.dtype)

        pe = p[l] @ w_ple[l]
        gate = jax.nn.sigmoid(rms_norm(h, ple_norm_g[l]) @ w_ple_gate[l])
        h = h + (pe * gate).astype(h.dtype)
    return rms_norm(h, final_norm_g)
```

```cpp
#include <hip/hip_runtime.h>
#include <hip/hip_cooperative_groups.h>
#include <cstdio>
#include <cstdint>
namespace cg = cooperative_groups;

#define LAS __attribute__((address_space(3)))
typedef unsigned short bf16_t;
typedef short bf16x8 __attribute__((ext_vector_type(8)));
typedef float f32x4 __attribute__((ext_vector_type(4)));
typedef float f32x2 __attribute__((ext_vector_type(2)));
typedef unsigned u32x4 __attribute__((ext_vector_type(4)));
typedef unsigned u32x2 __attribute__((ext_vector_type(2)));
typedef _Float16 f16x2 __attribute__((ext_vector_type(2)));

constexpr int MROWS = 32768;
constexpr int SEQ = 8192, DM = 1024;
constexpr int NPROJ = 5120;
constexpr int NWAVES = 8, NTHR = 512;
constexpr float EPS = 1e-6f;

constexpr size_t MiB = 1u << 20;
constexpr size_t WS_WIN = 0;
constexpr size_t WS_WOHG = 14 * MiB;
constexpr size_t WS_WGLU = 16 * MiB;
constexpr size_t WS_WOS5 = 17 * MiB;
constexpr size_t WS_WOUT = 18 * MiB;
constexpr size_t WS_WPLE = 20 * MiB;
constexpr size_t WS_WPG = 21 * MiB;
constexpr size_t WS_TCAT = 23 * MiB;
constexpr size_t WS_EMAT = 29 * MiB;
constexpr size_t WS_KTAB = 33 * MiB;
constexpr size_t WS_PB = 36 * MiB;
constexpr size_t WS_XB = 52 * MiB;
constexpr size_t WS_Q = 116 * MiB;
constexpr size_t WS_KK = 180 * MiB;
constexpr size_t WS_IV = 244 * MiB;
constexpr size_t WS_GH = 308 * MiB;
constexpr size_t WS_A5 = 372 * MiB;
constexpr size_t WS_ZS = 420 * MiB;
constexpr size_t WS_HGAGG = 452 * MiB;
constexpr size_t WS_E = 468 * MiB;
constexpr size_t WS_SMALL = 500 * MiB;
constexpr size_t WS_RINV0 = WS_SMALL;
constexpr size_t WS_SS1 = WS_SMALL + 256 * 1024;
constexpr size_t WS_SS2 = WS_SMALL + 512 * 1024;
constexpr size_t WS_LB = WS_SMALL + 768 * 1024;
constexpr size_t WS_HGDEC = WS_SMALL + 1024 * 1024;
constexpr size_t WS_CTL = WS_SMALL + 2048 * 1024;
constexpr int LDS_STG = 131072;
constexpr int LDS_MISC = 149504 - 64;
constexpr size_t WS_YS2 = WS_IV, WS_AHG = WS_Q, WS_MRG = WS_Q, WS_G8 = WS_KK  , WS_H1B = WS_KK, WS_YHG = WS_GH, WS_PE = WS_IV, WS_YSA = WS_HGAGG;

struct Prm {
    const float* in[23];
    float* out;
    unsigned char* ws;
    int ph_lo, ph_hi, coop, pad;
};
enum { I_X = 0, I_P, I_NORMG, I_WIN, I_HGLB, I_HGNG, I_WOHG, I_ARE, I_AIM, I_LOGDT, I_BRE, I_BIM, I_CRE, I_CIM, I_D, I_WGLU, I_BGLU, I_WOS5, I_WOUT, I_PLENG, I_WPLE, I_WPG, I_FNG };

__device__ __forceinline__ unsigned f2bf(float f) { unsigned u = __builtin_bit_cast(unsigned, f); return (u + 0x7fffu + ((u >> 16) & 1u)) >> 16; }
__device__ __forceinline__ unsigned pk2(float lo, float hi) { typedef float f2v __attribute__((ext_vector_type(2))); typedef __bf16 b2v __attribute__((ext_vector_type(2))); const f2v v = {lo, hi}; const b2v b = __builtin_convertvector(v, b2v); return __builtin_bit_cast(unsigned, b); }
__device__ __forceinline__ unsigned pkh2(float lo, float hi) { const f16x2 h = {(_Float16)lo, (_Float16)hi}; return __builtin_bit_cast(unsigned, h); }
__device__ __forceinline__ float bflo(unsigned w) { return __builtin_bit_cast(float, w << 16); }
__device__ __forceinline__ float bfhi(unsigned w) { return __builtin_bit_cast(float, w & 0xffff0000u); }
__device__ __forceinline__ float bf2f(bf16_t h) { return __builtin_bit_cast(float, (unsigned)h << 16); }
__device__ __forceinline__ float sigmoidf_(float z) { return __builtin_amdgcn_rcpf(1.0f + __builtin_amdgcn_exp2f(-1.4426950408889634f * z)); }
__device__ __forceinline__ float gelu_tanh(float x) { const float t = 1.5957691216057308f * (x + 0.044715f * x * x * x); return x * sigmoidf_(t); }
__device__ __forceinline__ float wave_sum(float v) {
#pragma unroll
    for (int o = 1; o < 64; o <<= 1) v += __shfl_xor(v, o);
    return v;
}
__device__ __forceinline__ int lane_id() { int l; asm volatile("v_mbcnt_lo_u32_b32 %0, -1, 0\n\tv_mbcnt_hi_u32_b32 %0, -1, %0" : "=v"(l)); return l; }
__device__ __forceinline__ void unpack8(const u32x4 w, float (&f)[8]) {
    f[0] = bflo(w.x); f[1] = bfhi(w.x); f[2] = bflo(w.y); f[3] = bfhi(w.y); f[4] = bflo(w.z); f[5] = bfhi(w.z); f[6] = bflo(w.w); f[7] = bfhi(w.w);
}
__device__ __forceinline__ u32x4 pack8(const float (&f)[8]) { u32x4 w; w.x = pk2(f[0], f[1]); w.y = pk2(f[2], f[3]); w.z = pk2(f[4], f[5]); w.w = pk2(f[6], f[7]); return w; }

namespace pg8 {
constexpr int BM = 256, BK = 64, HALF = 128, HTB = HALF * BK * 2, STAGE_BYTES = 8 * HTB, NXCD = 8, WGM = 8;
__host__ __device__ __forceinline__ int lds_byte(int r, int c) { const int st = (r >> 4) * 2 + (c >> 5), rr = r & 15, cc = c & 31, ob = rr * 64 + cc * 2; return st * 1024 + (ob ^ (((ob >> 9) & 1) << 5)); }
__host__ __device__ __forceinline__ void stage_rc(int b, int& R, int& C) { const int st = b / 1024, sb = b % 1024, swz = sb ^ (((sb >> 9) & 1) << 5); R = (st >> 1) * 16 + swz / 64; C = (st & 1) * 32 + (swz % 64) / 2; }
__host__ __device__ __forceinline__ int perm32(int rho) { const int n = rho >> 4, i = rho & 15; return 8 * (i >> 2) + 4 * n + (i & 3); }

struct Unit { int pm, pn; };
struct Gemm { const bf16_t* A; const bf16_t* Bt; int lda, ldb, K; };

struct StaticOrder {
    int nM, nN, nwg, G, c;
    __device__ void init(int M, int N, int G_, int c_) { nM = M / BM; nN = N / BM; nwg = nM * nN; G = G_; c = c_; }
    __device__ bool next(int i, Unit& u) const {
        const long L = (long)i * G + c; if (L >= nwg) return false;
        int wgid = (int)L; { const int q = nwg / NXCD, r = nwg % NXCD, xcd = wgid % NXCD, off = wgid / NXCD; wgid = (xcd < r ? xcd * (q + 1) : r * (q + 1) + (xcd - r) * q) + off; }
        const int nig = WGM * nN, gid = wgid / nig, fm = gid * WGM, gsz = (nM - fm) < WGM ? (nM - fm) : WGM;
        u.pm = fm + ((wgid % nig) % gsz); u.pn = (wgid % nig) / gsz; return true;
    }
};
struct RoundRange {
    StaticOrder base; int r0, r1;
    __device__ bool next(int i, Unit& u) const { if (r0 + i >= r1) return false; return base.next(r0 + i, u); }
};
struct GroupOrder {
    int G, c;
    __device__ bool next(int i, Unit& u) const { const int L = i * G + c; if (L >= 256) return false; u.pm = L; u.pn = L >> 3; return true; }
};

template <class Epi, class Sched>
__device__ __forceinline__ void gemm_phase(LAS unsigned char* lds, const Gemm g, const Sched& S, const Epi& E, int wave_id) {
    int tid = wave_id * 64 + lane_id(); asm volatile("" : "+v"(tid));
    const int wid = wave_id, lane = tid & 63, wr = wid >> 2, wc = wid & 3, fr = lane & 15, fq = lane >> 4;
    const int K = g.K, nt = K / BK;
    unsigned voffA[2], voffB[2];
#pragma unroll
    for (int i = 0; i < 2; ++i) { int R, C; stage_rc(tid * 16 + i * 8192, R, C); const int Rb = (R & ~31) + perm32(R & 31);
        voffA[i] = (unsigned)(R * g.lda + C) * 2u; voffB[i] = (unsigned)(Rb * g.ldb + C) * 2u; }
    const size_t kstep = (size_t)(BK * 2);
    const size_t hstepA = (size_t)HALF * g.lda * 2, hstepB = (size_t)HALF * g.ldb * 2;
    const size_t tstepA = 2 * hstepA, tstepB = 2 * hstepB;
    const unsigned ldsw = (unsigned)wid * 1024u;
    const int aoff = lds_byte(wr * 64 + fr, fq * 8), boff = lds_byte(wc * 32 + fr, fq * 8);
#define PG8_SA(b, h) (((b) * 2 + (h)) * HTB)
#define PG8_SB(b, h) ((4 + (b) * 2 + (h)) * HTB)
#define PG8_STAGE(bufoff, gbase, voff) do { _Pragma("unroll") for (int _i = 0; _i < 2; ++_i) \
        __builtin_amdgcn_global_load_lds((const unsigned*)((const char*)(gbase) + (voff)[_i]), (LAS unsigned*)(lds + (bufoff) + ldsw + _i * 8192), 16, 0, 0); } while (0)
#define PG8_LDA(dst, b, h) do { _Pragma("unroll") for (int m = 0; m < 4; ++m) _Pragma("unroll") for (int k = 0; k < 2; ++k) dst[m][k] = *(const LAS bf16x8*)(lds + PG8_SA(b, h) + aoff + m * 2048 + k * 1024); } while (0)
#define PG8_LDB(dst, b, h) do { _Pragma("unroll") for (int n = 0; n < 2; ++n) _Pragma("unroll") for (int k = 0; k < 2; ++k) dst[n][k] = *(const LAS bf16x8*)(lds + PG8_SB(b, h) + boff + n * 2048 + k * 1024); } while (0)
#define PG8_MMA(ai, bj, At, Bt) do { __builtin_amdgcn_s_setprio(1); _Pragma("unroll") for (int m = 0; m < 4; ++m) _Pragma("unroll") for (int n = 0; n < 2; ++n) _Pragma("unroll") for (int k = 0; k < 2; ++k) \
        acc[ai][bj][m][n] = __builtin_amdgcn_mfma_f32_16x16x32_bf16(Bt[n][k], At[m][k], acc[ai][bj][m][n], 0, 0, 0); __builtin_amdgcn_s_setprio(0); } while (0)
#define PG8_WAIT_V(n) asm volatile("s_waitcnt vmcnt(" #n ")" ::: "memory")
#define PG8_WAIT_L(n) asm volatile("s_waitcnt lgkmcnt(" #n ")" ::: "memory")
#define PG8_BAR __builtin_amdgcn_s_barrier()
#define PG8_SCHED __builtin_amdgcn_sched_barrier(0)
    Unit cur, nxt; int ui = 0;
    if (!S.next(0, cur)) return;
    f32x4 acc[2][2][4][2];
#pragma unroll
    for (int a = 0; a < 2; ++a)
#pragma unroll
        for (int b = 0; b < 2; ++b)
#pragma unroll
            for (int m = 0; m < 4; ++m)
#pragma unroll
                for (int n = 0; n < 2; ++n) acc[a][b][m][n] = (f32x4){0.f, 0.f, 0.f, 0.f};
    bf16x8 At[4][2], B0[2][2], B1[2][2];
    const char* cA = (const char*)g.A + (size_t)cur.pm * tstepA; const char* cB = (const char*)g.Bt + (size_t)cur.pn * tstepB;
    PG8_STAGE(PG8_SB(0, 0), cB, voffB); PG8_STAGE(PG8_SB(0, 1), cB + hstepB, voffB); PG8_STAGE(PG8_SA(0, 0), cA, voffA); PG8_STAGE(PG8_SA(0, 1), cA + hstepA, voffA);
    if (wr == 1) PG8_BAR;
    PG8_WAIT_V(2); PG8_BAR;
    PG8_STAGE(PG8_SB(1, 0), cB + kstep, voffB); PG8_STAGE(PG8_SA(1, 0), cA + kstep, voffA); PG8_STAGE(PG8_SB(1, 1), cB + hstepB + kstep, voffB);
    PG8_WAIT_V(6); PG8_BAR;
    for (;;) {
        const bool has_next = S.next(ui + 1, nxt);
        const char* nA = has_next ? (const char*)g.A + (size_t)nxt.pm * tstepA : cA; const char* nB = has_next ? (const char*)g.Bt + (size_t)nxt.pn * tstepB : cB;
        for (int t = 0; t < nt; t += 2) {
            const bool last = (t == nt - 2);
            const char* a1 = cA + (size_t)(t + 1) * kstep;
            const char* a2 = last ? nA : cA + (size_t)(t + 2) * kstep; const char* b2 = last ? nB : cB + (size_t)(t + 2) * kstep;
            const char* a3 = a2 + kstep; const char* b3 = b2 + kstep;
            PG8_LDB(B0, 0, 0); PG8_LDB(B1, 0, 1); PG8_SCHED; PG8_LDA(At, 0, 0); PG8_STAGE(PG8_SA(1, 1), a1 + hstepA, voffA);
            PG8_WAIT_V(8); PG8_WAIT_L(0); PG8_BAR; PG8_MMA(0, 0, At, B0); PG8_MMA(0, 1, At, B1); PG8_BAR; PG8_SCHED;
            PG8_LDA(At, 0, 1); PG8_STAGE(PG8_SB(0, 0), b2, voffB); PG8_STAGE(PG8_SB(0, 1), b2 + hstepB, voffB); PG8_STAGE(PG8_SA(0, 0), a2, voffA);
            PG8_WAIT_V(8); PG8_WAIT_L(0); PG8_BAR; PG8_MMA(1, 0, At, B0); PG8_MMA(1, 1, At, B1); PG8_BAR; PG8_SCHED;
            PG8_LDB(B0, 1, 0); PG8_LDB(B1, 1, 1); PG8_SCHED; PG8_LDA(At, 1, 0); PG8_STAGE(PG8_SA(0, 1), a2 + hstepA, voffA);
            PG8_WAIT_V(8); PG8_WAIT_L(0); PG8_BAR; PG8_MMA(0, 0, At, B0); PG8_MMA(0, 1, At, B1); PG8_BAR; PG8_SCHED;
            PG8_LDA(At, 1, 1); PG8_STAGE(PG8_SB(1, 0), b3, voffB); PG8_STAGE(PG8_SB(1, 1), b3 + hstepB, voffB); PG8_STAGE(PG8_SA(1, 0), a3, voffA);
            PG8_WAIT_V(8); PG8_WAIT_L(0); PG8_BAR; PG8_MMA(1, 0, At, B0); PG8_MMA(1, 1, At, B1); PG8_BAR; PG8_SCHED;
        }
        if (wr == 0) PG8_BAR;
        E(acc, cur, wr, wc, fr, fq);
        if (!has_next) break;
#pragma unroll
        for (int a = 0; a < 2; ++a)
#pragma unroll
            for (int b = 0; b < 2; ++b)
#pragma unroll
                for (int m = 0; m < 4; ++m)
#pragma unroll
                    for (int n = 0; n < 2; ++n) acc[a][b][m][n] = (f32x4){0.f, 0.f, 0.f, 0.f};
        cur = nxt; cA = nA; cB = nB; ++ui;
        if (wr == 1) PG8_BAR;
    }
    PG8_WAIT_V(0);
    PG8_BAR;
#undef PG8_SA
#undef PG8_SB
#undef PG8_STAGE
#undef PG8_LDA
#undef PG8_LDB
#undef PG8_MMA
#undef PG8_WAIT_V
#undef PG8_WAIT_L
#undef PG8_BAR
#undef PG8_SCHED
}
}

enum { EM_PROJ = 0, EM_GATES, EM_PLAIN, EM_GLU, EM_MERGE, EM_RES1, EM_RES2, EM_S5A, EM_S5C };
template <int MODE> struct Epi {
    unsigned char* ws; const float* x; float* out; const float* bglu; bf16_t* O; int ldc; LAS unsigned char* lds;
    __device__ __forceinline__ void stage512(const u32x4 a, const u32x4 b, unsigned char* g0, size_t ldb, int wr, int wc, int fr, int fq) const {
        LAS unsigned char* sb = lds + LDS_STG + wr * 8448;
        *(LAS u32x4*)(sb + fr * 528 + wc * 64 + fq * 16) = a; *(LAS u32x4*)(sb + fr * 528 + 256 + wc * 64 + fq * 16) = b;
        asm volatile("s_waitcnt lgkmcnt(0)" ::: "memory"); __builtin_amdgcn_s_barrier(); asm volatile("" ::: "memory");
        const int l = fq * 16 + fr;
#pragma unroll
        for (int q = 0; q < 2; ++q) { const int rl = (q * 4 + wc) * 2 + (l >> 5); const u32x4 v = *(const LAS u32x4*)(sb + rl * 528 + (l & 31) * 16); *(u32x4*)(g0 + (size_t)rl * ldb + (l & 31) * 16) = v; }
        asm volatile("s_waitcnt lgkmcnt(0)" ::: "memory"); __builtin_amdgcn_s_barrier(); asm volatile("" ::: "memory");
    }
    struct Pre { float rs; u32x4 a[2], b[2], c[2]; f32x4 f[2][2]; };
    __device__ __forceinline__ void load(Pre& p, const pg8::Unit& u, int ai, int m, int wr, int wc, int fr, int fq) const {
        const int row = u.pm * 256 + ai * 128 + wr * 64 + m * 16 + fr;
        if (MODE == EM_PROJ || MODE == EM_GATES) p.rs = ((const float*)(ws + WS_RINV0))[row];
        if (MODE == EM_RES2) p.rs = ((const float*)(ws + WS_SS1))[row];
#pragma unroll
        for (int bj = 0; bj < 2; ++bj) {
            const int ct = bj * 128 + wc * 32 + fq * 8; const size_t o = (size_t)row * 1024 + u.pn * 256 + ct;
            if (MODE == EM_MERGE) { const unsigned char* g8 = ws + WS_G8 + (size_t)row * 2048 + u.pn * 256 + ct; const u32x2 ga = *(const u32x2*)g8, gc = *(const u32x2*)(g8 + 1024);
                p.a[bj] = (u32x4){ga.x, ga.y, gc.x, gc.y}; p.b[bj] = *(const u32x4*)((const bf16_t*)(ws + WS_YHG) + o); }
            if (MODE == EM_RES1) p.a[bj] = *(const u32x4*)((const bf16_t*)(ws + WS_XB) + o);
            if (MODE == EM_RES2) { p.b[bj] = *(const u32x4*)((const bf16_t*)(ws + WS_H1B) + o); p.a[bj] = *(const u32x4*)((const bf16_t*)(ws + WS_PE) + o); }
            if (MODE == EM_GLU && bj == 0) p.a[0] = *(const u32x4*)((const bf16_t*)(ws + WS_ZS) + (size_t)row * 512 + u.pn * 128 + wc * 32 + fq * 8);
        }
    }
    __device__ __forceinline__ float compute(const Pre& p, f32x4 (&acc)[2][2][4][2], const f32x4 (&cv)[2][2], const pg8::Unit& u, int ai, int m, int wr, int wc, int fr, int fq) const {
        const int row = u.pm * 256 + ai * 128 + wr * 64 + m * 16 + fr;
        float ssq = 0.f;
        float rs = 1.f;
        u32x4 pk[2]; pk[0] = (u32x4){0u, 0u, 0u, 0u}; pk[1] = pk[0];
        const size_t trow = (size_t)(u.pm * 256 + ai * 128 + wr * 64 + m * 16);
        if (MODE == EM_PROJ || MODE == EM_GATES) rs = p.rs;
        if (MODE == EM_RES2) rs = rsqrtf(p.rs * (1.0f / 1024.0f) + EPS);
#pragma unroll
        for (int bj = 0; bj < 2; ++bj) {
            if ((MODE == EM_GLU || MODE == EM_S5A) && bj == 1) continue;
            const int ct = bj * 128 + wc * 32 + fq * 8;
            float v[8];
#pragma unroll
            for (int j = 0; j < 4; ++j) { v[j] = acc[ai][bj][m][0][j]; v[4 + j] = acc[ai][bj][m][1][j]; }
            if (MODE == EM_PROJ) {
                const int pn = u.pn;
                if (pn < 16) {
                    const int sec = pn >> 2, col = (pn & 3) * 256 + ct; const size_t o = (size_t)row * 1024 + col;
                    if (sec == 0) { float w[8];
#pragma unroll
                        for (int j = 0; j < 8; ++j) w[j] = v[j] * rs;
                        __builtin_nontemporal_store(pack8(w), (u32x4*)((bf16_t*)(ws + WS_Q) + o));
                    } else if (sec == 1) {
                        float lf[8];
#pragma unroll
                        for (int j = 0; j < 8; ++j) { const float lb = j < 4 ? cv[bj][0][j] : cv[bj][1][j - 4]; const float sg = sigmoidf_(v[j] * rs); lf[j] = __logf(lb + (1.f - lb) * sg); }
                        u32x4 hw; hw.x = pkh2(lf[0], lf[1]); hw.y = pkh2(lf[2], lf[3]); hw.z = pkh2(lf[4], lf[5]); hw.w = pkh2(lf[6], lf[7]);
                        __builtin_nontemporal_store(hw, (u32x4*)((_Float16*)out + o));
                    } else if (sec == 2) { float w[8];
#pragma unroll
                        for (int j = 0; j < 8; ++j) w[j] = v[j] * rs;
                        __builtin_nontemporal_store(pack8(w), (u32x4*)((bf16_t*)(ws + WS_IV) + o));
                    } else { float w[8];
#pragma unroll
                        for (int j = 0; j < 8; ++j) { const float z = v[j] * rs; w[j] = z * sigmoidf_(z); }
                        __builtin_nontemporal_store(pack8(w), (u32x4*)((bf16_t*)(ws + WS_GH) + o));
                    }
                } else if (pn < 18) {
                    const int col5 = (pn - 16) * 256 + ct, g = col5 >> 4, c = col5 & 15; float w[8];
#pragma unroll
                    for (int j = 0; j < 8; ++j) w[j] = v[j] * rs;
                    *(u32x4*)((bf16_t*)(ws + WS_A5) + ((size_t)(g * 2048 + (row >> 4)) * 384 + (row & 15) * 16 + c)) = pack8(w);
                } else {
                    const int col = (pn - 18) * 256 + ct; float w[8];
#pragma unroll
                    for (int j = 0; j < 8; ++j) { const float z = v[j] * rs; w[j] = z * sigmoidf_(z); }
                    __builtin_nontemporal_store(pack8(w), (u32x4*)((bf16_t*)(ws + WS_ZS) + (size_t)row * 512 + col));
                }
            } else if (MODE == EM_GATES) {
                const int col = u.pn * 256 + ct; float w[8];
#pragma unroll
                for (int j = 0; j < 8; ++j) w[j] = sigmoidf_(v[j] * rs) * 255.0f + 0.5f;
                u32x2 cd; cd.x = (unsigned)w[0] | ((unsigned)w[1] << 8) | ((unsigned)w[2] << 16) | ((unsigned)w[3] << 24); cd.y = (unsigned)w[4] | ((unsigned)w[5] << 8) | ((unsigned)w[6] << 16) | ((unsigned)w[7] << 24);
                *(u32x2*)(ws + WS_G8 + (size_t)row * 2048 + col) = cd;
            } else if (MODE == EM_PLAIN) {
                pk[bj] = pack8(v);
            } else if (MODE == EM_GLU) {
                const int col = u.pn * 128 + wc * 32 + fq * 8;
                float zs[8]; unpack8(p.a[0], zs);
                float w[8];
#pragma unroll
                for (int j = 0; j < 8; ++j) { const float a = v[j] + (j < 4 ? cv[0][0][j] : cv[0][1][j - 4]); const float b = (j < 4 ? acc[ai][1][m][0][j] : acc[ai][1][m][1][j - 4]) + (j < 4 ? cv[1][0][j] : cv[1][1][j - 4]); w[j] = a * sigmoidf_(b) * zs[j]; }
                *(u32x4*)((bf16_t*)(ws + WS_YS2) + (size_t)row * 512 + col) = pack8(w);
            } else if (MODE == EM_MERGE) {
                const size_t o = (size_t)row * 1024 + u.pn * 256 + ct;
                float b[8]; unpack8(p.b[bj], b);
                float w[8];
#pragma unroll
                for (int j = 0; j < 8; ++j) { const unsigned wa = j < 4 ? p.a[bj].x : p.a[bj].y, wc2 = j < 4 ? p.a[bj].z : p.a[bj].w; const int sh = 8 * (j & 3);
                    const float ga = (float)((wa >> sh) & 255u) * (1.0f / 255.0f), gc = (float)((wc2 >> sh) & 255u) * (1.0f / 255.0f); w[j] = ga * b[j] + gc * v[j]; }
                pk[bj] = pack8(w); (void)o;
            } else if (MODE == EM_RES1) {
                const size_t o = (size_t)row * 1024 + u.pn * 256 + ct;
                float w[8], xr[8]; unpack8(p.a[bj], xr);
#pragma unroll
                for (int j = 0; j < 8; ++j) { w[j] = v[j] + xr[j]; ssq += w[j] * w[j]; }
                pk[bj] = pack8(w); (void)o;
            } else if (MODE == EM_RES2) {
                const size_t o = (size_t)row * 1024 + u.pn * 256 + ct;
                float pe[8], h1[8]; unpack8(p.a[bj], pe); unpack8(p.b[bj], h1);
                float w[8];
#pragma unroll
                for (int j = 0; j < 8; ++j) { w[j] = h1[j] + pe[j] * sigmoidf_(v[j] * rs); ssq += w[j] * w[j]; }
                acc[ai][bj][m][0] = (f32x4){w[0], w[1], w[2], w[3]}; acc[ai][bj][m][1] = (f32x4){w[4], w[5], w[6], w[7]};
                (void)o;
            } else if (MODE == EM_S5A) {
                float* e = (float*)(ws + WS_E) + (size_t)row * 128 + ct;
                *(f32x4*)e = (f32x4){v[0], v[1], v[2], v[3]}; *(f32x4*)(e + 4) = (f32x4){v[4], v[5], v[6], v[7]};
            } else if (MODE == EM_S5C) {
                const int g = u.pn, cr = row - g * 2048; const int tok = cr * 16 + (ct >> 4);
                float w[8];
#pragma unroll
                for (int j = 0; j < 8; ++j) w[j] = gelu_tanh(v[j]);
                *(u32x4*)((bf16_t*)(ws + WS_YSA) + (size_t)tok * 512 + g * 16 + (ct & 15)) = pack8(w);
            }
        }
        if (MODE == EM_PLAIN) stage512(pk[0], pk[1], (unsigned char*)O + (trow * ldc + u.pn * 256) * 2, (size_t)ldc * 2, wr, wc, fr, fq);
        if (MODE == EM_MERGE) stage512(pk[0], pk[1], ws + WS_MRG + (trow * 1024 + u.pn * 256) * 2, 2048, wr, wc, fr, fq);
        if (MODE == EM_RES1) stage512(pk[0], pk[1], ws + WS_H1B + (trow * 1024 + u.pn * 256) * 2, 2048, wr, wc, fr, fq);
        if (MODE == EM_RES1 || MODE == EM_RES2) { ssq += __shfl_xor(ssq, 16); ssq += __shfl_xor(ssq, 32); }
        return ssq;
    }
    __device__ __forceinline__ void operator()(f32x4 (&acc)[2][2][4][2], const pg8::Unit& u, int wr, int wc, int fr, int fq) const {
        f32x4 cv[2][2];
#pragma unroll
        for (int bj = 0; bj < 2; ++bj)
#pragma unroll
            for (int q = 0; q < 2; ++q) cv[bj][q] = (f32x4){0.f, 0.f, 0.f, 0.f};
        if (MODE == EM_PROJ) { if ((u.pn >> 2) == 1) {
#pragma unroll
            for (int bj = 0; bj < 2; ++bj) { const float* lb = (const float*)(ws + WS_LB) + (u.pn & 3) * 256 + bj * 128 + wc * 32 + fq * 8; cv[bj][0] = *(const f32x4*)lb; cv[bj][1] = *(const f32x4*)(lb + 4); } } }
        if (MODE == EM_GLU) { const int col = u.pn * 128 + wc * 32 + fq * 8;
            cv[0][0] = *(const f32x4*)(bglu + col); cv[0][1] = *(const f32x4*)(bglu + col + 4); cv[1][0] = *(const f32x4*)(bglu + 512 + col); cv[1][1] = *(const f32x4*)(bglu + 512 + col + 4); }
        if (MODE == EM_RES2) {
#pragma unroll
            for (int bj = 0; bj < 2; ++bj) { const float* fg = x + u.pn * 256 + bj * 128 + wc * 32 + fq * 8; cv[bj][0] = *(const f32x4*)fg; cv[bj][1] = *(const f32x4*)(fg + 4); } }
        constexpr int NB = (MODE == EM_RES1 || MODE == EM_MERGE) ? 4 : (MODE == EM_RES2 ? 2 : 8);
        float ssqv[8];
#pragma unroll
        for (int b0 = 0; b0 < 8; b0 += NB) {
            Pre pb[NB];
#pragma unroll
            for (int k = 0; k < NB; ++k) load(pb[k], u, (b0 + k) >> 2, (b0 + k) & 3, wr, wc, fr, fq);
#pragma unroll
            for (int k = 0; k < NB; ++k) ssqv[b0 + k] = compute(pb[k], acc, cv, u, (b0 + k) >> 2, (b0 + k) & 3, wr, wc, fr, fq);
        }
        if (MODE == EM_RES1 || MODE == EM_RES2) {
#pragma unroll
            for (int it = 0; it < 8; ++it) { const int row = u.pm * 256 + (it >> 2) * 128 + wr * 64 + (it & 3) * 16 + fr;
                if (fq == 0 && ldc == 0) atomicAdd((float*)(ws + (MODE == EM_RES1 ? WS_SS1 : WS_SS2)) + row, ssqv[it]); }
        }
        if (MODE == EM_RES2) {
            asm volatile("s_waitcnt vmcnt(0)" ::: "memory");
            __syncthreads();
            unsigned* cnt = (unsigned*)(ws + WS_CTL + 16384) + u.pm * 16;
            if (wr == 0 && wc == 0 && fr == 0 && fq == 0 && ldc == 0) {
                __hip_atomic_fetch_add(cnt, 1u, __ATOMIC_RELAXED, __HIP_MEMORY_SCOPE_AGENT);
                unsigned sp = 0;
                while (__hip_atomic_load(cnt, __ATOMIC_RELAXED, __HIP_MEMORY_SCOPE_AGENT) < 4u) { __builtin_amdgcn_s_sleep(1); if (++sp > (1u << 24)) break; }
                asm volatile("s_waitcnt vmcnt(0)" ::: "memory");
            }
            __syncthreads();
            float ssr[8];
#pragma unroll
            for (int k = 0; k < 8; ++k) ssr[k] = __hip_atomic_load((float*)(ws + WS_SS2) + (u.pm * 256 + (k >> 2) * 128 + wr * 64 + (k & 3) * 16 + fr), __ATOMIC_RELAXED, __HIP_MEMORY_SCOPE_AGENT);
#pragma unroll
            for (int ai = 0; ai < 2; ++ai)
#pragma unroll
                for (int m = 0; m < 4; ++m) {
                    const int row = u.pm * 256 + ai * 128 + wr * 64 + m * 16 + fr;
                    const float ss = ssr[ai * 4 + m];
                    const float r2 = rsqrtf(ss * (1.0f / 1024.0f) + EPS);
#pragma unroll
                    for (int bj = 0; bj < 2; ++bj) { float* o = out + (size_t)row * 1024 + u.pn * 256 + bj * 128 + wc * 32 + fq * 8;
                        *(f32x4*)o = acc[ai][bj][m][0] * r2 * cv[bj][0]; *(f32x4*)(o + 4) = acc[ai][bj][m][1] * r2 * cv[bj][1]; }
                }
        }
    }
};

__device__ __forceinline__ void s5_ktab_item(const struct Prm& P, LAS float* scr, int item, int lane);
__device__ __forceinline__ void s5_emat_item(const struct Prm& P, int item, int lane);
__device__ __forceinline__ void s5_tcarry_item(const struct Prm& P, int item, int lane);
__device__ __forceinline__ int glu_dest(int n) { return n < 512 ? ((n >> 7) * 256 + (n & 127)) : ((((n - 512) >> 7) * 256) + 128 + ((n - 512) & 127)); }
__device__ __forceinline__ void transpose_item(const float* W, int K, int N, bf16_t* WT, const float* kscale, bool glu, LAS float* scr, int item, int lane) {
    const int nblk = N / 32, kb = item / nblk, nb = item % nblk, k0 = 64 * kb, n0 = 32 * nb;
#pragma unroll 8
    for (int i = 0; i < 32; ++i) { const int kk = 2 * i + (lane >> 5); const float sc = kscale ? kscale[k0 + kk] : 1.f; scr[kk * 33 + (lane & 31)] = W[(size_t)(k0 + kk) * N + n0 + (lane & 31)] * sc; }
    asm volatile("s_waitcnt lgkmcnt(0)" ::: "memory");
    const int c = lane & 7;
#pragma unroll
    for (int j = 0; j < 4; ++j) { const int n = (lane >> 3) + 8 * j; const LAS float* s = scr + (8 * c) * 33 + n;
        u32x4 o; o.x = pk2(s[0 * 33], s[1 * 33]); o.y = pk2(s[2 * 33], s[3 * 33]); o.z = pk2(s[4 * 33], s[5 * 33]); o.w = pk2(s[6 * 33], s[7 * 33]);
        const int dn = glu ? glu_dest(n0 + n) : (n0 + n);
        *(u32x4*)(WT + (size_t)dn * K + k0 + 8 * c) = o; }
    asm volatile("s_waitcnt lgkmcnt(0)" ::: "memory");
}

__device__ __forceinline__ void p0_prologue(const Prm& P, LAS unsigned char* lds, int gw, int NGW, int wave, int lane) {
    unsigned char* ws = P.ws;
    LAS float* scr = (LAS float*)(lds + wave * 16384);
    constexpr int I_IN = 16 * 224, I_SQ = 16 * 32, I_GLU = 8 * 32, I_OS5 = 8 * 32, I_PLE = 4 * 32;
    constexpr int NITEMS = I_IN + I_SQ + I_GLU + I_OS5 + I_SQ + I_PLE + I_SQ;
    for (int it = gw; it < NITEMS; it += NGW) {
        int r = it;
        if (r < I_IN) { transpose_item(P.in[I_WIN], 1024, 7168, (bf16_t*)(ws + WS_WIN), P.in[I_NORMG], false, scr, r, lane); continue; } r -= I_IN;
        if (r < I_SQ) { transpose_item(P.in[I_WOHG], 1024, 1024, (bf16_t*)(ws + WS_WOHG), nullptr, false, scr, r, lane); continue; } r -= I_SQ;
        if (r < I_GLU) { transpose_item(P.in[I_WGLU], 512, 1024, (bf16_t*)(ws + WS_WGLU), nullptr, true, scr, r, lane); continue; } r -= I_GLU;
        if (r < I_OS5) { transpose_item(P.in[I_WOS5], 512, 1024, (bf16_t*)(ws + WS_WOS5), nullptr, false, scr, r, lane); continue; } r -= I_OS5;
        if (r < I_SQ) { transpose_item(P.in[I_WOUT], 1024, 1024, (bf16_t*)(ws + WS_WOUT), nullptr, false, scr, r, lane); continue; } r -= I_SQ;
        if (r < I_PLE) { transpose_item(P.in[I_WPLE], 256, 1024, (bf16_t*)(ws + WS_WPLE), nullptr, false, scr, r, lane); continue; } r -= I_PLE;
        transpose_item(P.in[I_WPG], 1024, 1024, (bf16_t*)(ws + WS_WPG), P.in[I_PLENG], false, scr, r, lane);
    }
    const float* x = P.in[I_X]; const float* p = P.in[I_P];
#define P0_LOAD(V, PV, M0) do { _Pragma("unroll") for (int r = 0; r < 2; ++r) { const f32x4* xr = (const f32x4*)(x + (size_t)((M0) + r) * 1024) + lane; \
            _Pragma("unroll") for (int j = 0; j < 4; ++j) V[r][j] = __builtin_nontemporal_load(xr + 64 * j); \
            PV[r] = __builtin_nontemporal_load((const f32x4*)(p + (size_t)((M0) + r) * 256) + lane); } } while (0)
#define P0_PROC(V, PV, M0) do { _Pragma("unroll") for (int r = 0; r < 2; ++r) { const int m = (M0) + r; float s = 0.f; \
            _Pragma("unroll") for (int j = 0; j < 4; ++j) s += (V[r][j].x * V[r][j].x + V[r][j].y * V[r][j].y) + (V[r][j].z * V[r][j].z + V[r][j].w * V[r][j].w); \
            s = wave_sum(s); \
            u32x2* o8 = (u32x2*)((bf16_t*)(ws + WS_XB) + (size_t)m * 1024) + lane; \
            _Pragma("unroll") for (int j = 0; j < 4; ++j) { u32x2 w; w.x = pk2(V[r][j].x, V[r][j].y); w.y = pk2(V[r][j].z, V[r][j].w); o8[64 * j] = w; } \
            u32x2 w; w.x = pk2(PV[r].x, PV[r].y); w.y = pk2(PV[r].z, PV[r].w); *((u32x2*)((bf16_t*)(ws + WS_PB) + (size_t)m * 256) + lane) = w; \
            if (lane == 0) { ((float*)(ws + WS_RINV0))[m] = rsqrtf(s * (1.0f / 1024.0f) + EPS); ((float*)(ws + WS_SS1))[m] = 0.f; ((float*)(ws + WS_SS2))[m] = 0.f; } } } while (0)
    {
        f32x4 va[2][4], vb[2][4]; f32x4 pa[2], pb2[2];
        const int step = NGW * 2; int m0 = gw * 2;
        if (m0 < MROWS) P0_LOAD(va, pa, m0);
        while (m0 < MROWS) {
            const int m1 = m0 + step;
            if (m1 < MROWS) P0_LOAD(vb, pb2, m1);
            P0_PROC(va, pa, m0);
            if (m1 >= MROWS) break;
            const int m2 = m1 + step;
            if (m2 < MROWS) P0_LOAD(va, pa, m2);
            P0_PROC(vb, pb2, m1);
            m0 = m2;
        }
    }
#undef P0_LOAD
#undef P0_PROC
    for (int it = gw; it < 512; it += NGW) s5_ktab_item(P, scr, it, lane);
    for (int it = gw; it < 8192; it += NGW) { s5_emat_item(P, it, lane); s5_tcarry_item(P, it, lane); }
    const int gt = gw * 64 + lane;
    if (gt < 1024) { const float a0 = P.in[I_HGLB][gt], a1 = P.in[I_HGLB][1024 + gt]; ((float*)(ws + WS_LB))[gt] = 1.0f / (1.0f + __expf(a1 - a0)); }
}

__device__ __forceinline__ void lam_pow(float ar, float ai, float dt, float d, float& pr, float& pi) { const float m = __expf(d * ar * dt); float s, c; sincosf(d * ai * dt, &s, &c); pr = m * c; pi = m * s; }
__device__ __forceinline__ void zoh_scale(float ar, float ai, float dt, float& sr, float& si) {
    const float th = ai * dt; float s, c; sincosf(th, &s, &c); const float m = __expf(ar * dt); const float sh = sinf(0.5f * th);
    const float nr = expm1f(ar * dt) * c - 2.0f * sh * sh, li = m * s; const float den = ar * ar + ai * ai;
    sr = (nr * ar + li * ai) / den; si = (li * ar - nr * ai) / den;
}
__device__ __forceinline__ void s5_ktab_item(const Prm& P, LAS float* scr, int item, int lane) {
    const int g = item >> 4, d = item & 15, n = lane;
    const float dt = __expf(P.in[I_LOGDT][g]); const float ar = P.in[I_ARE][g * 64 + n], ai = P.in[I_AIM][g * 64 + n];
    float pr, pi; lam_pow(ar, ai, dt, (float)d, pr, pi); float sr, si; zoh_scale(ar, ai, dt, sr, si);
    const float qr = pr * sr - pi * si, qi = pr * si + pi * sr;
#pragma unroll
    for (int c = 0; c < 16; ++c) { const float br = P.in[I_BRE][(g * 64 + n) * 16 + c], bi = P.in[I_BIM][(g * 64 + n) * 16 + c]; scr[n * 33 + c] = qr * br - qi * bi; scr[n * 33 + 16 + c] = qr * bi + qi * br; }
    asm volatile("s_waitcnt lgkmcnt(0)" ::: "memory");
    const int cp = lane >> 2, c0 = (lane & 3) * 4; float o[4] = {0.f, 0.f, 0.f, 0.f};
    const float* cre = P.in[I_CRE] + (g * 16 + cp) * 64; const float* cim = P.in[I_CIM] + (g * 16 + cp) * 64;
    for (int nn = 0; nn < 64; ++nn) { const float cr = cre[nn], ci = cim[nn];
#pragma unroll
        for (int j = 0; j < 4; ++j) o[j] += cr * scr[nn * 33 + c0 + j] - ci * scr[nn * 33 + 16 + c0 + j]; }
    if (d == 0) {
#pragma unroll
        for (int j = 0; j < 4; ++j) if (c0 + j == cp) o[j] += P.in[I_D][g * 16 + cp]; }
    *(f32x4*)((float*)(P.ws + WS_KTAB) + ((size_t)(g * 16 + d) * 16 + cp) * 16 + c0) = (f32x4){o[0], o[1], o[2], o[3]};
    asm volatile("s_waitcnt lgkmcnt(0)" ::: "memory");
}
__device__ __forceinline__ void s5_emat_item(const Prm& P, int item, int lane) {
    const int g = item >> 8, n2 = item & 255; u32x2 w; w.x = 0u; w.y = 0u;
    if (n2 < 128) {
        const int n = n2 & 63, part = n2 >> 6, s = lane >> 2, c0 = (lane & 3) * 4;
        const float dt = __expf(P.in[I_LOGDT][g]); const float ar = P.in[I_ARE][g * 64 + n], ai = P.in[I_AIM][g * 64 + n];
        float pr, pi; lam_pow(ar, ai, dt, (float)(15 - s), pr, pi); float sr, si; zoh_scale(ar, ai, dt, sr, si);
        const float qr = pr * sr - pi * si, qi = pr * si + pi * sr; float o[4];
#pragma unroll
        for (int j = 0; j < 4; ++j) { const float br = P.in[I_BRE][(g * 64 + n) * 16 + c0 + j], bi = P.in[I_BIM][(g * 64 + n) * 16 + c0 + j]; o[j] = part ? (qr * bi + qi * br) : (qr * br - qi * bi); }
        w.x = pk2(o[0], o[1]); w.y = pk2(o[2], o[3]);
    }
    *((u32x2*)((bf16_t*)(P.ws + WS_EMAT) + (size_t)item * 256) + lane) = w;
}
__device__ __forceinline__ void s5_tcarry_item(const Prm& P, int item, int lane) {
    const int g = item >> 8, t = (item >> 4) & 15, cp = item & 15; const float dt = __expf(P.in[I_LOGDT][g]); float o[2];
#pragma unroll
    for (int j = 0; j < 2; ++j) { const int n2 = lane * 2 + j, n = n2 & 63, part = n2 >> 6;
        const float ar = P.in[I_ARE][g * 64 + n], ai = P.in[I_AIM][g * 64 + n]; float pr, pi; lam_pow(ar, ai, dt, (float)(t + 1), pr, pi);
        const float cr = P.in[I_CRE][(g * 16 + cp) * 64 + n], ci = P.in[I_CIM][(g * 16 + cp) * 64 + n];
        o[j] = part ? -(cr * pi + ci * pr) : (cr * pr - ci * pi); }
    *((unsigned*)((bf16_t*)(P.ws + WS_TCAT) + (size_t)item * 384 + 256) + lane) = pk2(o[0], o[1]);
}
__device__ __forceinline__ void s5_toeplitz_item(const Prm& P, int item, int lane) {
    const int g = item >> 8, t = (item >> 4) & 15, cp = item & 15, s = lane >> 2, c0 = (lane & 3) * 4; u32x2 w; w.x = 0u; w.y = 0u;
    if (s <= t) { const f32x4 k = *(const f32x4*)((const float*)(P.ws + WS_KTAB) + ((size_t)(g * 16 + (t - s)) * 16 + cp) * 16 + c0); w.x = pk2(k[0], k[1]); w.y = pk2(k[2], k[3]); }
    *((u32x2*)((bf16_t*)(P.ws + WS_TCAT) + (size_t)item * 384) + lane) = w;
}
__device__ __forceinline__ void s5_scan(const Prm& P, LAS unsigned char* lds, int item, int wave) {
    const int lane = lane_id(), tid = wave * 64 + lane, nl = tid & 31, ss = tid >> 5, b = item >> 6, g = (item >> 1) & 31, half = item & 1, n = half * 32 + nl;
    const float dt = __expf(P.in[I_LOGDT][g]); const float ar = P.in[I_ARE][g * 64 + n], ai = P.in[I_AIM][g * 64 + n];
    float Lr, Li; lam_pow(ar, ai, dt, 16.0f, Lr, Li);
    float L8r = Lr, L8i = Li;
#pragma unroll
    for (int q = 0; q < 3; ++q) { const float a = L8r * L8r - L8i * L8i, c = 2.0f * L8r * L8i; L8r = a; L8i = c; }
    LAS float* tile = (LAS float*)lds; LAS float* agg = tile + 128 * 64;
    const float* E = (const float*)(P.ws + WS_E); bf16_t* A5 = (bf16_t*)(P.ws + WS_A5);
    float car = 0.f, cai = 0.f;
    f32x4 ev[4];
#define S5_ELOAD(PIECE) do { const size_t rb_ = (size_t)g * 2048 + b * 512 + (PIECE) * 128; _Pragma("unroll") for (int i = 0; i < 4; ++i) { const int idx = tid + i * 512, r = idx >> 4, part = (idx >> 3) & 1, c4 = idx & 7; \
            ev[i] = *(const f32x4*)(E + (rb_ + r) * 128 + part * 64 + half * 32 + c4 * 4); } } while (0)
    S5_ELOAD(0);
    for (int piece = 0; piece < 4; ++piece) {
        const size_t rowbase = (size_t)g * 2048 + b * 512 + piece * 128;
#pragma unroll
        for (int i = 0; i < 4; ++i) { const int idx = tid + i * 512, r = idx >> 4, part = (idx >> 3) & 1, c4 = idx & 7;
            *(LAS f32x4*)(tile + r * 64 + part * 32 + c4 * 4) = ev[i]; }
        if (piece + 1 < 4) S5_ELOAD(piece + 1);
        __syncthreads();
        const int r0 = ss * 8; float xr[8], xi[8]; float pr = 0.f, pi = 0.f;
#pragma unroll
        for (int j = 0; j < 8; ++j) { xr[j] = pr; xi[j] = pi; const float er = tile[(r0 + j) * 64 + nl], ei = tile[(r0 + j) * 64 + 32 + nl];
            const float a = Lr * pr - Li * pi + er, c = Lr * pi + Li * pr + ei; pr = a; pi = c; }
        agg[ss * 64 + nl] = pr; agg[ss * 64 + 32 + nl] = pi;
        __syncthreads();
        float cr = car, ci = cai, mr = 0.f, mi = 0.f;
#pragma unroll
        for (int s2 = 0; s2 < 16; ++s2) { if (s2 == ss) { mr = cr; mi = ci; } const float a = L8r * cr - L8i * ci + agg[s2 * 64 + nl], c = L8r * ci + L8i * cr + agg[s2 * 64 + 32 + nl]; cr = a; ci = c; }
        car = cr; cai = ci;
        float pwr = 1.f, pwi = 0.f;
#pragma unroll
        for (int j = 0; j < 8; ++j) { const float hr = xr[j] + pwr * mr - pwi * mi, hi = xi[j] + pwr * mi + pwi * mr;
            bf16_t* dst = A5 + (rowbase + r0 + j) * 384 + 256 + n; dst[0] = (bf16_t)f2bf(hr); dst[64] = (bf16_t)f2bf(hi);
            const float a = pwr * Lr - pwi * Li, c = pwr * Li + pwi * Lr; pwr = a; pwi = c; }
        __syncthreads();
    }
#undef S5_ELOAD
}

typedef float f32x16 __attribute__((ext_vector_type(16)));
constexpr int HL_QM = 0, HL_KM = 17408, HL_OS = 0, HL_QD = 34816, HL_KDT = 52224, HL_IVT = 70656, HL_ST = 89088, HL_PP = 123904, HL_TOT = 133120, HL_DC = 137216;
template <bool FULL, bool STORE = true>
__device__ __forceinline__ void hg_item(const Prm& P, LAS unsigned char* lds, int item, int wave) {
    unsigned char* ws = P.ws; const int lane = lane_id(), tid = wave * 64 + lane;
    const int b = item >> 6, h = (item >> 3) & 7, seg = item & 7;
    const int l31 = lane & 31, lh = lane >> 5;
    const int k2 = lane * 2, tg = wave;
    const int kb = wave >> 1, vb0 = (wave & 1) * 2;
    const _Float16* LF = (const _Float16*)P.out; const bf16_t* Q = (const bf16_t*)(ws + WS_Q); const bf16_t* IV = (const bf16_t*)(ws + WS_IV); const bf16_t* GH = (const bf16_t*)(ws + WS_GH);
    bf16_t* AHG = (bf16_t*)(ws + WS_AHG);
    float* AGG = (float*)(ws + WS_HGAGG); float* DEC = (float*)(ws + WS_HGDEC);
    f32x16 S[2];
#pragma unroll
    for (int i = 0; i < 2; ++i)
#pragma unroll
        for (int r = 0; r < 16; ++r) S[i][r] = 0.f;
    float sumlog0 = 0.f, sumlog1 = 0.f;
    if (FULL) {
        for (int s2 = 0; s2 < seg; ++s2) { const int it2 = item - seg + s2;
#pragma unroll
            for (int g4 = 0; g4 < 4; ++g4) { const f32x4 d = *(const f32x4*)(DEC + it2 * 128 + kb * 32 + 8 * g4 + 4 * lh);
#pragma unroll
                for (int i = 0; i < 2; ++i)
#pragma unroll
                    for (int j = 0; j < 4; ++j) { const int r = 4 * g4 + j; S[i][r] = d[j] * S[i][r] + AGG[(size_t)((it2 * 8 + wave) * 2 + i) * 1024 + r * 64 + lane]; } } }
#pragma unroll
        for (int i = 0; i < 2; ++i)
#pragma unroll
            for (int g4 = 0; g4 < 4; ++g4) { u32x2 w; w.x = pk2(S[i][4 * g4], S[i][4 * g4 + 1]); w.y = pk2(S[i][4 * g4 + 2], S[i][4 * g4 + 3]);
                *(LAS u32x2*)(lds + HL_ST + ((vb0 + i) * 32 + l31) * 272 + (kb * 32 + 8 * g4 + 4 * lh) * 2) = w; }
        for (int e = tid; e < 32 * 16; e += NTHR) { const int t = e >> 4, c = e & 15; *(LAS unsigned*)(lds + HL_PP + t * 144 + 64 + c * 4) = 0u; }
    }
    float c0[8], c1[8]; unsigned qw[8], ivw[8]; u32x4 ghw0, ghw1;
#define HG_LOADS(CH) do { const size_t row0_ = (size_t)b * SEQ + seg * 1024 + (CH) * 64; _Pragma("unroll") for (int i = 0; i < 8; ++i) { const size_t o = (row0_ + tg * 8 + i) * 1024 + h * 128 + k2; \
            const unsigned lw_ = FULL ? __builtin_nontemporal_load((const unsigned*)(LF + o)) : *(const unsigned*)(LF + o); const f16x2 l = __builtin_bit_cast(f16x2, lw_); c0[i] = (float)l.x; c1[i] = (float)l.y; \
            ivw[i] = FULL ? __builtin_nontemporal_load((const unsigned*)(IV + o)) : *(const unsigned*)(IV + o); if (FULL) qw[i] = __builtin_nontemporal_load((const unsigned*)(Q + o)); } \
        if (FULL) { const size_t oo_ = (row0_ + (tid >> 3)) * 1024 + h * 128 + (tid & 7) * 16; ghw0 = __builtin_nontemporal_load((const u32x4*)(GH + oo_)); ghw1 = __builtin_nontemporal_load((const u32x4*)(GH + oo_ + 8)); } } while (0)
    HG_LOADS(0);
    for (int ch = 0; ch < 16; ++ch) {
        const size_t row0 = (size_t)b * SEQ + seg * 1024 + ch * 64;
        float ka[8], kc[8], f0[8], f1[8]; float t0 = 0.f, t1 = 0.f;
#pragma unroll
        for (int i = 0; i < 8; ++i) { f0[i] = __expf(c0[i]); f1[i] = __expf(c1[i]); ka[i] = 1.0f - f0[i]; kc[i] = 1.0f - f1[i]; t0 += c0[i]; t1 += c1[i]; }
        *(LAS f32x2*)(lds + HL_TOT + (tg * 128 + k2) * 4) = (f32x2){t0, t1};
        __syncthreads();
        float off0 = 0.f, off1 = 0.f, bm0 = 0.f, bm1 = 0.f, bl0 = 0.f, bl1 = 0.f;
#pragma unroll
        for (int g8 = 0; g8 < 8; ++g8) { const f32x2 t2 = *(const LAS f32x2*)(lds + HL_TOT + (g8 * 128 + k2) * 4); if (g8 < tg) { off0 += t2.x; off1 += t2.y; } if (g8 < 4) { bm0 += t2.x; bm1 += t2.y; } bl0 += t2.x; bl1 += t2.y; }
        {
            float kd0[8], kd1[8], iv0[8], iv1[8];
            float e0 = __expf(off0 + c0[0] - bm0), e1 = __expf(off1 + c1[0] - bm1);
            const float ebm0 = __expf(bm0), ebm1 = __expf(bm1), ebl0 = __expf(bl0 - bm0), ebl1 = __expf(bl1 - bm1);
#pragma unroll
            for (int i = 0; i < 8; ++i) { if (i) { e0 *= f0[i]; e1 *= f1[i]; }
                const float r0 = __builtin_amdgcn_rcpf(e0), r1 = __builtin_amdgcn_rcpf(e1);
                kd0[i] = ka[i] * r0 * ebl0; kd1[i] = kc[i] * r1 * ebl1; iv0[i] = bflo(ivw[i]); iv1[i] = bfhi(ivw[i]);
                if (FULL) { const float qa = bflo(qw[i]), qc = bfhi(qw[i]); const int t = tg * 8 + i;
                    *(LAS unsigned*)(lds + HL_QM + t * 272 + k2 * 2) = pk2(qa * e0, qc * e1);
                    *(LAS unsigned*)(lds + HL_KM + t * 272 + k2 * 2) = pk2(ka[i] * r0, kc[i] * r1);
                    *(LAS unsigned*)(lds + HL_QD + t * 272 + k2 * 2) = pk2(qa * e0 * ebm0, qc * e1 * ebm1); } }
            *(LAS u32x4*)(lds + HL_KDT + k2 * 144 + tg * 16) = pack8(kd0); *(LAS u32x4*)(lds + HL_KDT + (k2 + 1) * 144 + tg * 16) = pack8(kd1);
            *(LAS u32x4*)(lds + HL_IVT + k2 * 144 + tg * 16) = pack8(iv0); *(LAS u32x4*)(lds + HL_IVT + (k2 + 1) * 144 + tg * 16) = pack8(iv1);
            if (tg == 0) { *(LAS f32x2*)(lds + HL_DC + k2 * 4) = (f32x2){__expf(bl0), __expf(bl1)}; sumlog0 += bl0; sumlog1 += bl1; }
        }
        const u32x4 gcur0 = ghw0, gcur1 = ghw1;
        if (ch + 1 < 16) HG_LOADS(ch + 1);
        __syncthreads();
        if (FULL) {
            if (wave < 3) { const int tb = wave ? 1 : 0, sb = wave == 2 ? 1 : 0; f32x16 sc;
#pragma unroll
                for (int r = 0; r < 16; ++r) sc[r] = 0.f;
#pragma unroll
                for (int ks = 0; ks < 8; ++ks) { const bf16x8 a = *(const LAS bf16x8*)(lds + HL_QM + (tb * 32 + l31) * 272 + ks * 32 + lh * 16), bb = *(const LAS bf16x8*)(lds + HL_KM + (sb * 32 + l31) * 272 + ks * 32 + lh * 16);
                    sc = __builtin_amdgcn_mfma_f32_32x32x16_bf16(a, bb, sc, 0, 0, 0); }
#pragma unroll
                for (int r = 0; r < 16; ++r) { const int t = tb * 32 + (r & 3) + 8 * (r >> 2) + 4 * lh, s = sb * 32 + l31; *(LAS bf16_t*)(lds + HL_PP + t * 144 + s * 2) = (bf16_t)f2bf(s <= t ? sc[r] : 0.f); }
            }
            __syncthreads();
            { const int tb = wave >> 2, vb = wave & 3; f32x16 o;
#pragma unroll
                for (int r = 0; r < 16; ++r) o[r] = 0.f;
#pragma unroll
                for (int ks = 0; ks < 4; ++ks) { if (ks < 2 || tb) { const bf16x8 a = *(const LAS bf16x8*)(lds + HL_PP + (tb * 32 + l31) * 144 + ks * 32 + lh * 16), bb = *(const LAS bf16x8*)(lds + HL_IVT + (vb * 32 + l31) * 144 + ks * 32 + lh * 16);
                        o = __builtin_amdgcn_mfma_f32_32x32x16_bf16(a, bb, o, 0, 0, 0); } }
#pragma unroll
                for (int ks = 0; ks < 8; ++ks) { const bf16x8 a = *(const LAS bf16x8*)(lds + HL_QD + (tb * 32 + l31) * 272 + ks * 32 + lh * 16), bb = *(const LAS bf16x8*)(lds + HL_ST + (vb * 32 + l31) * 272 + ks * 32 + lh * 16);
                    o = __builtin_amdgcn_mfma_f32_32x32x16_bf16(a, bb, o, 0, 0, 0); }
#pragma unroll
                for (int r = 0; r < 16; ++r) { const int t = tb * 32 + (r & 3) + 8 * (r >> 2) + 4 * lh; *(LAS float*)(lds + HL_OS + t * 528 + (vb * 32 + l31) * 4) = o[r]; }
            }
        }
#pragma unroll
        for (int g4 = 0; g4 < 4; ++g4) { const f32x4 d = *(const LAS f32x4*)(lds + HL_DC + (kb * 32 + 8 * g4 + 4 * lh) * 4);
#pragma unroll
            for (int i = 0; i < 2; ++i)
#pragma unroll
                for (int j = 0; j < 4; ++j) S[i][4 * g4 + j] *= d[j]; }
#pragma unroll
        for (int ks = 0; ks < 4; ++ks) { const bf16x8 a = *(const LAS bf16x8*)(lds + HL_KDT + (kb * 32 + l31) * 144 + ks * 32 + lh * 16);
#pragma unroll
            for (int i = 0; i < 2; ++i) { const bf16x8 bb = *(const LAS bf16x8*)(lds + HL_IVT + ((vb0 + i) * 32 + l31) * 144 + ks * 32 + lh * 16); S[i] = __builtin_amdgcn_mfma_f32_32x32x16_bf16(a, bb, S[i], 0, 0, 0); } }
        if (FULL) {
            __syncthreads();
#pragma unroll
            for (int i = 0; i < 2; ++i)
#pragma unroll
                for (int g4 = 0; g4 < 4; ++g4) { u32x2 w; w.x = pk2(S[i][4 * g4], S[i][4 * g4 + 1]); w.y = pk2(S[i][4 * g4 + 2], S[i][4 * g4 + 3]);
                    *(LAS u32x2*)(lds + HL_ST + ((vb0 + i) * 32 + l31) * 272 + (kb * 32 + 8 * g4 + 4 * lh) * 2) = w; }
            { const int t = tid >> 3, vs = (tid & 7) * 16; float o[16]; float ss = 0.f;
#pragma unroll
                for (int q4 = 0; q4 < 4; ++q4) { const f32x4 x4 = *(const LAS f32x4*)(lds + HL_OS + t * 528 + (vs + 4 * q4) * 4);
#pragma unroll
                    for (int j = 0; j < 4; ++j) { o[4 * q4 + j] = x4[j]; ss += x4[j] * x4[j]; } }
                ss += __shfl_xor(ss, 1); ss += __shfl_xor(ss, 2); ss += __shfl_xor(ss, 4);
                const float r = rsqrtf(ss * (1.0f / 128.0f) + EPS);
                const size_t oo = (row0 + t) * 1024 + h * 128 + vs; const float* gn = P.in[I_HGNG] + h * 128 + vs;
                float g0[8], g1[8]; unpack8(gcur0, g0); unpack8(gcur1, g1);
                float w0[8], w1[8];
#pragma unroll
                for (int j = 0; j < 8; ++j) { w0[j] = o[j] * r * gn[j] * g0[j]; w1[j] = o[8 + j] * r * gn[8 + j] * g1[j]; }
                if (STORE) { *(u32x4*)(AHG + oo) = pack8(w0); *(u32x4*)(AHG + oo + 8) = pack8(w1); }
            }
        }
    }
#undef HG_LOADS
    if (!FULL) {
#pragma unroll
        for (int i = 0; i < 2; ++i)
#pragma unroll
            for (int r = 0; r < 16; ++r) AGG[(size_t)((item * 8 + wave) * 2 + i) * 1024 + r * 64 + lane] = S[i][r];
        if (tg == 0) *(f32x2*)(DEC + item * 128 + k2) = (f32x2){__expf(sumlog0), __expf(sumlog1)};
    }
    __syncthreads();
}


#define XB_TMO      128
#define XB_XCNT(j)  (256  + 64 * (j))
#define XB_XSUB(j)  (1280 + 64 * (j))
#define XB_XGEN(j)  (2304 + 64 * (j))
#define XB_TOP      3328
#define XB_TOPGEN   3392
#define XCD_BAR_WORDS 3456
#define XB_SPIN_CAP (1u << 22)
__device__ __forceinline__ unsigned xb_ld(unsigned* p)              { return __hip_atomic_load(p, __ATOMIC_RELAXED, __HIP_MEMORY_SCOPE_AGENT); }
__device__ __forceinline__ unsigned xb_add(unsigned* p, unsigned v) { return __hip_atomic_fetch_add(p, v, __ATOMIC_RELAXED, __HIP_MEMORY_SCOPE_AGENT); }
__device__ __forceinline__ unsigned xb_xcc_id() { return (unsigned)__builtin_amdgcn_s_getreg((3 << 11) | 20) & 0xFu; }
#define XB_SPIN(cond, bar) do { unsigned _sp = 0; while (cond) { __builtin_amdgcn_s_sleep(1); \
    if ((++_sp & 255u) == 0u) { if (xb_ld(&(bar)[XB_TMO])) break; if (_sp > XB_SPIN_CAP) { atomicAdd(&(bar)[XB_TMO], 1u); break; } } } } while (0)
struct XcdBarrier { unsigned* bar; unsigned x; volatile LAS unsigned* st; int wave; };
__device__ __forceinline__ XcdBarrier xcd_barrier_post(unsigned* bar, volatile LAS unsigned* st, int wave) {
    XcdBarrier b; b.bar = bar; b.x = xb_xcc_id(); b.st = st; b.wave = wave;
    if (wave == 0 && lane_id() == 0) (void)xb_add(&bar[XB_XCNT(b.x)], 1u);
    return b;
}
__device__ __forceinline__ void xcd_barrier_complete(unsigned* bar, unsigned x, unsigned& nloc, unsigned& nx) {
    const unsigned G = gridDim.x * gridDim.y * gridDim.z;
    unsigned sum, cnt, mine, sp = 0u;
    for (;;) {
        sum = 0u; cnt = 0u; mine = 0u;
#pragma unroll
        for (unsigned j = 0; j < 16; ++j) { const unsigned c = xb_ld(&bar[XB_XCNT(j)]); sum += c; cnt += (c > 0u) ? 1u : 0u; mine = (j == x) ? c : mine; }
        if (sum == G) break;
        __builtin_amdgcn_s_sleep(1);
        if ((++sp & 255u) == 0u) { if (xb_ld(&bar[XB_TMO])) break; if (sp > XB_SPIN_CAP) { atomicAdd(&bar[XB_TMO], 1u); break; } }
    }
    nloc = mine > 0u ? mine : 1u; nx = cnt > 0u ? cnt : 1u;
}
__device__ __forceinline__ void xcd_barrier(const XcdBarrier& b) {
    asm volatile("s_waitcnt vmcnt(0)" ::: "memory");
    __syncthreads();
    if (b.wave == 0 && lane_id() == 0) {
        unsigned* bar = b.bar;
        __builtin_amdgcn_s_waitcnt(0);
        unsigned nloc = b.st[0], nx = b.st[1];
        if (nloc == 0u) { xcd_barrier_complete(bar, b.x, nloc, nx); b.st[0] = nloc; b.st[1] = nx; }
        const unsigned old = xb_add(&bar[XB_XSUB(b.x)], 1u);
        const unsigned gen = old / nloc;
        if (old + 1u == (gen + 1u) * nloc) {
            __builtin_amdgcn_fence(__ATOMIC_RELEASE, "agent");
            asm volatile("s_waitcnt vmcnt(0)" ::: "memory");
            const unsigned og = xb_add(&bar[XB_TOP], 1u);
            const unsigned tg = og / nx;
            if (og + 1u == (tg + 1u) * nx) xb_add(&bar[XB_TOPGEN], 1u);
            else XB_SPIN(xb_ld(&bar[XB_TOPGEN]) == tg, bar);
            __builtin_amdgcn_fence(__ATOMIC_ACQUIRE, "agent");
            xb_add(&bar[XB_XGEN(b.x)], 1u);
            asm volatile("s_waitcnt vmcnt(0)" ::: "memory");
        } else {
            XB_SPIN(xb_ld(&bar[XB_XGEN(b.x)]) == gen, bar);
            __builtin_amdgcn_fence(__ATOMIC_ACQUIRE, "agent");
            asm volatile("s_waitcnt vmcnt(0)" ::: "memory");
        }
    }
    __syncthreads();
}

__global__ void __launch_bounds__(NTHR, 2) fwd_megakernel(Prm P) {
    extern __shared__ __attribute__((aligned(16))) unsigned char lds_raw[];
    LAS unsigned char* lds = (LAS unsigned char*)lds_raw;
    cg::grid_group grid = cg::this_grid();
    const int wave = __builtin_amdgcn_readfirstlane(threadIdx.x >> 6);
    if (P.coop == 2) grid.sync();
#define lane lane_id()
#define tid (wave * 64 + lane_id())
    const int G = gridDim.x, bx = blockIdx.x;
    const int gw = bx * NWAVES + wave, NGW = G * NWAVES;
    unsigned char* ws = P.ws;
    const int lo = P.ph_lo, hi = P.ph_hi;
#define IN(k) (lo <= (k) && (k) < hi)
    volatile LAS unsigned* bst = (volatile LAS unsigned*)(lds + LDS_MISC);
    if (tid < 16) bst[tid] = 0u;
    __syncthreads();
    XcdBarrier xbar = xcd_barrier_post((unsigned*)(ws + WS_CTL), bst, wave);
#define SEAM(k) do { if (IN(k) && IN((k) + 1)) xcd_barrier(xbar); } while (0)

    if (IN(0)) p0_prologue(P, lds, gw, NGW, wave, lane);
    SEAM(0);
    if (IN(1)) {
        { pg8::Gemm g{(const bf16_t*)(ws + WS_XB), (const bf16_t*)(ws + WS_WIN), 1024, 1024, 1024}; pg8::StaticOrder S; S.init(MROWS, NPROJ, G, bx);
          Epi<EM_PROJ> E{ws, nullptr, P.out, nullptr, nullptr, 0, lds}; pg8::gemm_phase(lds, g, S, E, wave); }
    }
    SEAM(1);
#define GATES_ROUNDS(R0, R1) do { pg8::Gemm g{(const bf16_t*)(ws + WS_XB), (const bf16_t*)(ws + WS_WIN) + (size_t)NPROJ * 1024, 1024, 1024, 1024}; pg8::RoundRange S; S.base.init(MROWS, 2048, G, bx); S.r0 = (R0); S.r1 = (R1); \
        Epi<EM_GATES> E{ws, nullptr, nullptr, nullptr, nullptr, 0, lds}; pg8::gemm_phase(lds, g, S, E, wave); } while (0)
    if (IN(2)) {
        if (bx & 1) GATES_ROUNDS(0, 2);
        for (int it = gw; it < 8192; it += NGW) s5_toeplitz_item(P, it, lane);
        { pg8::Gemm g{(const bf16_t*)(ws + WS_A5), (const bf16_t*)(ws + WS_EMAT), 384, 256, 256}; pg8::GroupOrder S{G, bx};
          Epi<EM_S5A> E{ws, nullptr, nullptr, nullptr, nullptr, 0, lds}; pg8::gemm_phase(lds, g, S, E, wave); }
        for (int it = bx; it < 256; it += G) hg_item<false>(P, lds, it, wave);
        if (!(bx & 1)) GATES_ROUNDS(0, 2);
    }
    SEAM(2);
    if (IN(3)) {
        if (!(bx & 1)) GATES_ROUNDS(2, 4);
        for (int it = bx; it < 256; it += G) s5_scan(P, lds, it, wave);
        for (int it = bx; it < 256; it += G) hg_item<true>(P, lds, it, wave);
        if (bx & 1) GATES_ROUNDS(2, 4);
    }
    SEAM(3);
    if (IN(4)) {
        { pg8::Gemm g{(const bf16_t*)(ws + WS_A5), (const bf16_t*)(ws + WS_TCAT), 384, 384, 384}; pg8::GroupOrder S{G, bx};
          Epi<EM_S5C> E{ws, nullptr, nullptr, nullptr, nullptr, 0, lds}; pg8::gemm_phase(lds, g, S, E, wave); }
        { pg8::Gemm g{(const bf16_t*)(ws + WS_AHG), (const bf16_t*)(ws + WS_WOHG), 1024, 1024, 1024}; pg8::StaticOrder S; S.init(MROWS, 1024, G, bx);
          Epi<EM_PLAIN> E{ws, nullptr, nullptr, nullptr, (bf16_t*)(ws + WS_YHG), 1024, lds}; pg8::gemm_phase(lds, g, S, E, wave); }
    }
    SEAM(4);
    if (IN(5)) {
        { pg8::Gemm g{(const bf16_t*)(ws + WS_YSA), (const bf16_t*)(ws + WS_WGLU), 512, 512, 512}; pg8::StaticOrder S; S.init(MROWS, 1024, G, bx);
          Epi<EM_GLU> E{ws, nullptr, nullptr, P.in[I_BGLU], nullptr, 0, lds}; pg8::gemm_phase(lds, g, S, E, wave); }
    }
    SEAM(5);
    if (IN(6)) {
        { pg8::Gemm g{(const bf16_t*)(ws + WS_YS2), (const bf16_t*)(ws + WS_WOS5), 512, 512, 512}; pg8::StaticOrder S; S.init(MROWS, 1024, G, bx);
          Epi<EM_MERGE> E{ws, nullptr, nullptr, nullptr, nullptr, 0, lds}; pg8::gemm_phase(lds, g, S, E, wave); }
    }
    SEAM(6);
    if (IN(7)) {
        { pg8::Gemm g{(const bf16_t*)(ws + WS_MRG), (const bf16_t*)(ws + WS_WOUT), 1024, 1024, 1024}; pg8::StaticOrder S; S.init(MROWS, 1024, G, bx);
          Epi<EM_RES1> E{ws, P.in[I_X], P.out, nullptr, nullptr, 0, lds}; pg8::gemm_phase(lds, g, S, E, wave); }
        { pg8::Gemm g{(const bf16_t*)(ws + WS_PB), (const bf16_t*)(ws + WS_WPLE), 256, 256, 256}; pg8::StaticOrder S; S.init(MROWS, 1024, G, bx);
          Epi<EM_PLAIN> E{ws, nullptr, nullptr, nullptr, (bf16_t*)(ws + WS_PE), 1024, lds}; pg8::gemm_phase(lds, g, S, E, wave); }
    }
    SEAM(7);
    if (IN(8)) {
        { pg8::Gemm g{(const bf16_t*)(ws + WS_H1B), (const bf16_t*)(ws + WS_WPG), 1024, 1024, 1024}; pg8::StaticOrder S; S.init(MROWS, 1024, G, bx);
          Epi<EM_RES2> E{ws, P.in[I_FNG], P.out, nullptr, nullptr, 0, lds}; pg8::gemm_phase(lds, g, S, E, wave); }
    }
    SEAM(8);
    if (IN(9)) {
        const float* fg = P.in[I_FNG];
        f32x4 gv[4];
#pragma unroll
        for (int j = 0; j < 4; ++j) gv[j] = *((const f32x4*)fg + lane + 64 * j);
        for (int m = gw; m < MROWS; m += NGW) {
            const float r = rsqrtf(((const float*)(ws + WS_SS2))[m] * (1.0f / 1024.0f) + EPS);
            f32x4* o = (f32x4*)(P.out + (size_t)m * 1024) + lane;
#pragma unroll
            for (int j = 0; j < 4; ++j) { f32x4 v = o[64 * j]; v = v * r * gv[j]; o[64 * j] = v; }
        }
    }
#undef IN
#undef SEAM
#undef lane
#undef tid
}

constexpr int LDS_BYTES = 149504;
constexpr int NPHASE = 9;
extern "C" void kernel_launch(void* const* d_in, const int* in_sizes, int n_in, void* d_out, int out_size, void* d_ws, size_t ws_size, hipStream_t stream) {
    static int grid = 0;
    if (grid == 0) {
        int dev = 0, cus = 0, per_cu = 0;
        hipGetDevice(&dev);
        hipDeviceGetAttribute(&cus, hipDeviceAttributeMultiprocessorCount, dev);
        hipFuncSetAttribute((const void*)fwd_megakernel, hipFuncAttributeMaxDynamicSharedMemorySize, LDS_BYTES);
        hipOccupancyMaxActiveBlocksPerMultiprocessor(&per_cu, (const void*)fwd_megakernel, NTHR, LDS_BYTES);
        if (per_cu < 1) per_cu = 1;
        grid = cus * 1;
        if (grid <= 0) grid = 256;
        if (ws_size < 504 * MiB) fprintf(stderr, "kernel_launch: workspace too small (%zu)\n", ws_size);
    }
    (void)hipMemsetAsync((char*)d_ws + WS_CTL, 0, 32768, stream);
    Prm p{};
    for (int i = 0; i < 23; ++i) p.in[i] = (const float*)d_in[i];
    p.out = (float*)d_out; p.ws = (unsigned char*)d_ws; p.ph_lo = 0; p.ph_hi = NPHASE; p.coop = 1; p.pad = 0;
    void* args[] = {&p};
    hipError_t e = hipLaunchCooperativeKernel((const void*)fwd_megakernel, dim3(grid), dim3(NTHR), args, LDS_BYTES, stream);
    if (e != hipSuccess) fprintf(stderr, "cooperative launch failed: %s (grid %d)\n", hipGetErrorString(e), grid);
}
```

```cpp
#include <hip/hip_runtime.h>
#include <hip/hip_cooperative_groups.h>
#include <cstdio>
#include <cstdint>
namespace cg = cooperative_groups;

#define LAS __attribute__((address_space(3)))
typedef unsigned short bf16_t;
typedef short bf16x8 __attribute__((ext_vector_type(8)));
typedef float f32x4 __attribute__((ext_vector_type(4)));
typedef float f32x2 __attribute__((ext_vector_type(2)));
typedef unsigned u32x4 __attribute__((ext_vector_type(4)));
typedef unsigned u32x2 __attribute__((ext_vector_type(2)));
typedef _Float16 f16x2 __attribute__((ext_vector_type(2)));

constexpr int MROWS = 32768;
constexpr int SEQ = 8192, DM = 1024;
constexpr int NPROJ = 5120;
constexpr int NWAVES = 8, NTHR = 512;
constexpr float EPS = 1e-6f;

constexpr size_t MiB = 1u << 20;
constexpr size_t WS_WIN = 0;
constexpr size_t WS_WOHG = 14 * MiB;
constexpr size_t WS_WGLU = 16 * MiB;
constexpr size_t WS_WOS5 = 17 * MiB;
constexpr size_t WS_WOUT = 18 * MiB;
constexpr size_t WS_WPLE = 20 * MiB;
constexpr size_t WS_WPG = 21 * MiB;
constexpr size_t WS_TCAT = 23 * MiB;
constexpr size_t WS_EMAT = 29 * MiB;
constexpr size_t WS_KTAB = 33 * MiB;
constexpr size_t WS_PB = 36 * MiB;
constexpr size_t WS_XB = 52 * MiB;
constexpr size_t WS_Q = 116 * MiB;
constexpr size_t WS_KK = 180 * MiB;
constexpr size_t WS_IV = 244 * MiB;
constexpr size_t WS_GH = 308 * MiB;
constexpr size_t WS_A5 = 372 * MiB;
constexpr size_t WS_ZS = 420 * MiB;
constexpr size_t WS_HGAGG = 452 * MiB;
constexpr size_t WS_E = 468 * MiB;
constexpr size_t WS_SMALL = 500 * MiB;
constexpr size_t WS_RINV0 = WS_SMALL;
constexpr size_t WS_SS1 = WS_SMALL + 256 * 1024;
constexpr size_t WS_SS2 = WS_SMALL + 512 * 1024;
constexpr size_t WS_LB = WS_SMALL + 768 * 1024;
constexpr size_t WS_HGDEC = WS_SMALL + 1024 * 1024;
constexpr size_t WS_CTL = WS_SMALL + 2048 * 1024;
constexpr int LDS_STG = 131072;
constexpr int LDS_MISC = 149504 - 64;
constexpr size_t WS_YS2 = WS_IV, WS_AHG = WS_Q, WS_MRG = WS_Q, WS_G8 = WS_KK  , WS_H1B = WS_KK, WS_YHG = WS_GH, WS_PE = WS_IV, WS_YSA = WS_HGAGG;

struct Prm {
    const float* in[23];
    float* out;
    unsigned char* ws;
    int ph_lo, ph_hi, coop, pad;
};
enum { I_X = 0, I_P, I_NORMG, I_WIN, I_HGLB, I_HGNG, I_WOHG, I_ARE, I_AIM, I_LOGDT, I_BRE, I_BIM, I_CRE, I_CIM, I_D, I_WGLU, I_BGLU, I_WOS5, I_WOUT, I_PLENG, I_WPLE, I_WPG, I_FNG };

__device__ __forceinline__ unsigned f2bf(float f) { unsigned u = __builtin_bit_cast(unsigned, f); return (u + 0x7fffu + ((u >> 16) & 1u)) >> 16; }
__device__ __forceinline__ unsigned pk2(float lo, float hi) { typedef float f2v __attribute__((ext_vector_type(2))); typedef __bf16 b2v __attribute__((ext_vector_type(2))); const f2v v = {lo, hi}; const b2v b = __builtin_convertvector(v, b2v); return __builtin_bit_cast(unsigned, b); }
__device__ __forceinline__ unsigned pkh2(float lo, float hi) { const f16x2 h = {(_Float16)lo, (_Float16)hi}; return __builtin_bit_cast(unsigned, h); }
__device__ __forceinline__ float bflo(unsigned w) { return __builtin_bit_cast(float, w << 16); }
__device__ __forceinline__ float bfhi(unsigned w) { return __builtin_bit_cast(float, w & 0xffff0000u); }
__device__ __forceinline__ float bf2f(bf16_t h) { return __builtin_bit_cast(float, (unsigned)h << 16); }
__device__ __forceinline__ float sigmoidf_(float z) { return __builtin_amdgcn_rcpf(1.0f + __builtin_amdgcn_exp2f(-1.4426950408889634f * z)); }
__device__ __forceinline__ float gelu_tanh(float x) { const float t = 1.5957691216057308f * (x + 0.044715f * x * x * x); return x * sigmoidf_(t); }
__device__ __forceinline__ float wave_sum(float v) {
#pragma unroll
    for (int o = 1; o < 64; o <<= 1) v += __shfl_xor(v, o);
    return v;
}
__device__ __forceinline__ int lane_id() { int l; asm volatile("v_mbcnt_lo_u32_b32 %0, -1, 0\n\tv_mbcnt_hi_u32_b32 %0, -1, %0" : "=v"(l)); return l; }
__device__ __forceinline__ void unpack8(const u32x4 w, float (&f)[8]) {
    f[0] = bflo(w.x); f[1] = bfhi(w.x); f[2] = bflo(w.y); f[3] = bfhi(w.y); f[4] = bflo(w.z); f[5] = bfhi(w.z); f[6] = bflo(w.w); f[7] = bfhi(w.w);
}
__device__ __forceinline__ u32x4 pack8(const float (&f)[8]) { u32x4 w; w.x = pk2(f[0], f[1]); w.y = pk2(f[2], f[3]); w.z = pk2(f[4], f[5]); w.w = pk2(f[6], f[7]); return w; }

namespace pg8 {
constexpr int BM = 256, BK = 64, HALF = 128, HTB = HALF * BK * 2, STAGE_BYTES = 8 * HTB, NXCD = 8, WGM = 8;
__host__ __device__ __forceinline__ int lds_byte(int r, int c) { const int st = (r >> 4) * 2 + (c >> 5), rr = r & 15, cc = c & 31, ob = rr * 64 + cc * 2; return st * 1024 + (ob ^ (((ob >> 9) & 1) << 5)); }
__host__ __device__ __forceinline__ void stage_rc(int b, int& R, int& C) { const int st = b / 1024, sb = b % 1024, swz = sb ^ (((sb >> 9) & 1) << 5); R = (st >> 1) * 16 + swz / 64; C = (st & 1) * 32 + (swz % 64) / 2; }
__host__ __device__ __forceinline__ int perm32(int rho) { const int n = rho >> 4, i = rho & 15; return 8 * (i >> 2) + 4 * n + (i & 3); }

struct Unit { int pm, pn; };
struct Gemm { const bf16_t* A; const bf16_t* Bt; int lda, ldb, K; };

struct StaticOrder {
    int nM, nN, nwg, G, c;
    __device__ void init(int M, int N, int G_, int c_) { nM = M / BM; nN = N / BM; nwg = nM * nN; G = G_; c = c_; }
    __device__ bool next(int i, Unit& u) const {
        const long L = (long)i * G + c; if (L >= nwg) return false;
        int wgid = (int)L; { const int q = nwg / NXCD, r = nwg % NXCD, xcd = wgid % NXCD, off = wgid / NXCD; wgid = (xcd < r ? xcd * (q + 1) : r * (q + 1) + (xcd - r) * q) + off; }
        const int nig = WGM * nN, gid = wgid / nig, fm = gid * WGM, gsz = (nM - fm) < WGM ? (nM - fm) : WGM;
        u.pm = fm + ((wgid % nig) % gsz); u.pn = (wgid % nig) / gsz; return true;
    }
};
struct RoundRange {
    StaticOrder base; int r0, r1;
    __device__ bool next(int i, Unit& u) const { if (r0 + i >= r1) return false; return base.next(r0 + i, u); }
};
struct GroupOrder {
    int G, c;
    __device__ bool next(int i, Unit& u) const { const int L = i * G + c; if (L >= 256) return false; u.pm = L; u.pn = L >> 3; return true; }
};

template <class Epi, class Sched>
__device__ __forceinline__ void gemm_phase(LAS unsigned char* lds, const Gemm g, const Sched& S, const Epi& E, int wave_id) {
    int tid = wave_id * 64 + lane_id(); asm volatile("" : "+v"(tid));
    const int wid = wave_id, lane = tid & 63, wr = wid >> 2, wc = wid & 3, fr = lane & 15, fq = lane >> 4;
    const int K = g.K, nt = K / BK;
    unsigned voffA[2], voffB[2];
#pragma unroll
    for (int i = 0; i < 2; ++i) { int R, C; stage_rc(tid * 16 + i * 8192, R, C); const int Rb = (R & ~31) + perm32(R & 31);
        voffA[i] = (unsigned)(R * g.lda + C) * 2u; voffB[i] = (unsigned)(Rb * g.ldb + C) * 2u; }
    const size_t kstep = (size_t)(BK * 2);
    const size_t hstepA = (size_t)HALF * g.lda * 2, hstepB = (size_t)HALF * g.ldb * 2;
    const size_t tstepA = 2 * hstepA, tstepB = 2 * hstepB;
    const unsigned ldsw = (unsigned)wid * 1024u;
    const int aoff = lds_byte(wr * 64 + fr, fq * 8), boff = lds_byte(wc * 32 + fr, fq * 8);
#define PG8_SA(b, h) (((b) * 2 + (h)) * HTB)
#define PG8_SB(b, h) ((4 + (b) * 2 + (h)) * HTB)
#define PG8_STAGE(bufoff, gbase, voff) do { _Pragma("unroll") for (int _i = 0; _i < 2; ++_i) \
        __builtin_amdgcn_global_load_lds((const unsigned*)((const char*)(gbase) + (voff)[_i]), (LAS unsigned*)(lds + (bufoff) + ldsw + _i * 8192), 16, 0, 0); } while (0)
#define PG8_LDA(dst, b, h) do { _Pragma("unroll") for (int m = 0; m < 4; ++m) _Pragma("unroll") for (int k = 0; k < 2; ++k) dst[m][k] = *(const LAS bf16x8*)(lds + PG8_SA(b, h) + aoff + m * 2048 + k * 1024); } while (0)
#define PG8_LDB(dst, b, h) do { _Pragma("unroll") for (int n = 0; n < 2; ++n) _Pragma("unroll") for (int k = 0; k < 2; ++k) dst[n][k] = *(const LAS bf16x8*)(lds + PG8_SB(b, h) + boff + n * 2048 + k * 1024); } while (0)
#define PG8_MMA(ai, bj, At, Bt) do { __builtin_amdgcn_s_setprio(1); _Pragma("unroll") for (int m = 0; m < 4; ++m) _Pragma("unroll") for (int n = 0; n < 2; ++n) _Pragma("unroll") for (int k = 0; k < 2; ++k) \
        acc[ai][bj][m][n] = __builtin_amdgcn_mfma_f32_16x16x32_bf16(Bt[n][k], At[m][k], acc[ai][bj][m][n], 0, 0, 0); __builtin_amdgcn_s_setprio(0); } while (0)
#define PG8_WAIT_V(n) asm volatile("s_waitcnt vmcnt(" #n ")" ::: "memory")
#define PG8_WAIT_L(n) asm volatile("s_waitcnt lgkmcnt(" #n ")" ::: "memory")
#define PG8_BAR __builtin_amdgcn_s_barrier()
#define PG8_SCHED __builtin_amdgcn_sched_barrier(0)
    Unit cur, nxt; int ui = 0;
    if (!S.next(0, cur)) return;
    f32x4 acc[2][2][4][2];
#pragma unroll
    for (int a = 0; a < 2; ++a)
#pragma unroll
        for (int b = 0; b < 2; ++b)
#pragma unroll
            for (int m = 0; m < 4; ++m)
#pragma unroll
                for (int n = 0; n < 2; ++n) acc[a][b][m][n] = (f32x4){0.f, 0.f, 0.f, 0.f};
    bf16x8 At[4][2], B0[2][2], B1[2][2];
    const char* cA = (const char*)g.A + (size_t)cur.pm * tstepA; const char* cB = (const char*)g.Bt + (size_t)cur.pn * tstepB;
    PG8_STAGE(PG8_SB(0, 0), cB, voffB); PG8_STAGE(PG8_SB(0, 1), cB + hstepB, voffB); PG8_STAGE(PG8_SA(0, 0), cA, voffA); PG8_STAGE(PG8_SA(0, 1), cA + hstepA, voffA);
    if (wr == 1) PG8_BAR;
    PG8_WAIT_V(2); PG8_BAR;
    PG8_STAGE(PG8_SB(1, 0), cB + kstep, voffB); PG8_STAGE(PG8_SA(1, 0), cA + kstep, voffA); PG8_STAGE(PG8_SB(1, 1), cB + hstepB + kstep, voffB);
    PG8_WAIT_V(6); PG8_BAR;
    for (;;) {
        const bool has_next = S.next(ui + 1, nxt);
        const char* nA = has_next ? (const char*)g.A + (size_t)nxt.pm * tstepA : cA; const char* nB = has_next ? (const char*)g.Bt + (size_t)nxt.pn * tstepB : cB;
        for (int t = 0; t < nt; t += 2) {
            const bool last = (t == nt - 2);
            const char* a1 = cA + (size_t)(t + 1) * kstep;
            const char* a2 = last ? nA : cA + (size_t)(t + 2) * kstep; const char* b2 = last ? nB : cB + (size_t)(t + 2) * kstep;
            const char* a3 = a2 + kstep; const char* b3 = b2 + kstep;
            PG8_LDB(B0, 0, 0); if (!Epi::HALF_N) PG8_LDB(B1, 0, 1); PG8_SCHED; PG8_LDA(At, 0, 0); PG8_STAGE(PG8_SA(1, 1), a1 + hstepA, voffA);
            PG8_WAIT_V(8); PG8_WAIT_L(0); PG8_BAR; PG8_MMA(0, 0, At, B0); if (!Epi::HALF_N) PG8_MMA(0, 1, At, B1); PG8_BAR; PG8_SCHED;
            PG8_LDA(At, 0, 1); PG8_STAGE(PG8_SB(0, 0), b2, voffB); PG8_STAGE(PG8_SB(0, 1), b2 + hstepB, voffB); PG8_STAGE(PG8_SA(0, 0), a2, voffA);
            PG8_WAIT_V(8); PG8_WAIT_L(0); PG8_BAR; PG8_MMA(1, 0, At, B0); if (!Epi::HALF_N) PG8_MMA(1, 1, At, B1); PG8_BAR; PG8_SCHED;
            PG8_LDB(B0, 1, 0); if (!Epi::HALF_N) PG8_LDB(B1, 1, 1); PG8_SCHED; PG8_LDA(At, 1, 0); PG8_STAGE(PG8_SA(0, 1), a2 + hstepA, voffA);
            PG8_WAIT_V(8); PG8_WAIT_L(0); PG8_BAR; PG8_MMA(0, 0, At, B0); if (!Epi::HALF_N) PG8_MMA(0, 1, At, B1); PG8_BAR; PG8_SCHED;
            PG8_LDA(At, 1, 1); PG8_STAGE(PG8_SB(1, 0), b3, voffB); PG8_STAGE(PG8_SB(1, 1), b3 + hstepB, voffB); PG8_STAGE(PG8_SA(1, 0), a3, voffA);
            PG8_WAIT_V(8); PG8_WAIT_L(0); PG8_BAR; PG8_MMA(1, 0, At, B0); if (!Epi::HALF_N) PG8_MMA(1, 1, At, B1); PG8_BAR; PG8_SCHED;
        }
        if (wr == 0) PG8_BAR;
        E(acc, cur, wr, wc, fr, fq);
        if (!has_next) break;
#pragma unroll
        for (int a = 0; a < 2; ++a)
#pragma unroll
            for (int b = 0; b < 2; ++b)
#pragma unroll
                for (int m = 0; m < 4; ++m)
#pragma unroll
                    for (int n = 0; n < 2; ++n) acc[a][b][m][n] = (f32x4){0.f, 0.f, 0.f, 0.f};
        cur = nxt; cA = nA; cB = nB; ++ui;
        if (wr == 1) PG8_BAR;
    }
    PG8_WAIT_V(0);
    PG8_BAR;
#undef PG8_SA
#undef PG8_SB
#undef PG8_STAGE
#undef PG8_LDA
#undef PG8_LDB
#undef PG8_MMA
#undef PG8_WAIT_V
#undef PG8_WAIT_L
#undef PG8_BAR
#undef PG8_SCHED
}
}

enum { EM_PROJ = 0, EM_GATES, EM_PLAIN, EM_GLU, EM_MERGE, EM_RES1, EM_RES2, EM_S5A, EM_S5C };
template <int MODE> struct Epi {
    static constexpr bool HALF_N = (MODE == EM_S5A);
    unsigned char* ws; const float* x; float* out; const float* bglu; bf16_t* O; int ldc; LAS unsigned char* lds;
    __device__ __forceinline__ void stage512(const u32x4 a, const u32x4 b, unsigned char* g0, size_t ldb, int wr, int wc, int fr, int fq) const {
        LAS unsigned char* sb = lds + LDS_STG + wr * 8448;
        *(LAS u32x4*)(sb + fr * 528 + wc * 64 + fq * 16) = a; *(LAS u32x4*)(sb + fr * 528 + 256 + wc * 64 + fq * 16) = b;
        asm volatile("s_waitcnt lgkmcnt(0)" ::: "memory"); __builtin_amdgcn_s_barrier(); asm volatile("" ::: "memory");
        const int l = fq * 16 + fr;
#pragma unroll
        for (int q = 0; q < 2; ++q) { const int rl = (q * 4 + wc) * 2 + (l >> 5); const u32x4 v = *(const LAS u32x4*)(sb + rl * 528 + (l & 31) * 16); *(u32x4*)(g0 + (size_t)rl * ldb + (l & 31) * 16) = v; }
        asm volatile("s_waitcnt lgkmcnt(0)" ::: "memory"); __builtin_amdgcn_s_barrier(); asm volatile("" ::: "memory");
    }
    struct Pre { float rs; u32x4 a[2], b[2], c[2]; f32x4 f[2][2]; };
    __device__ __forceinline__ void load(Pre& p, const pg8::Unit& u, int ai, int m, int wr, int wc, int fr, int fq) const {
        const int row = u.pm * 256 + ai * 128 + wr * 64 + m * 16 + fr;
        if (MODE == EM_PROJ || MODE == EM_GATES) p.rs = ((const float*)(ws + WS_RINV0))[row];
        if (MODE == EM_RES2) p.rs = ((const float*)(ws + WS_SS1))[row];
#pragma unroll
        for (int bj = 0; bj < 2; ++bj) {
            const int ct = bj * 128 + wc * 32 + fq * 8; const size_t o = (size_t)row * 1024 + u.pn * 256 + ct;
            if (MODE == EM_MERGE) { const unsigned char* g8 = ws + WS_G8 + (size_t)row * 2048 + u.pn * 256 + ct; const u32x2 ga = *(const u32x2*)g8, gc = *(const u32x2*)(g8 + 1024);
                p.a[bj] = (u32x4){ga.x, ga.y, gc.x, gc.y}; p.b[bj] = *(const u32x4*)((const bf16_t*)(ws + WS_YHG) + o); }
            if (MODE == EM_RES1) p.a[bj] = *(const u32x4*)((const bf16_t*)(ws + WS_XB) + o);
            if (MODE == EM_RES2) { p.b[bj] = *(const u32x4*)((const bf16_t*)(ws + WS_H1B) + o); p.a[bj] = *(const u32x4*)((const bf16_t*)(ws + WS_PE) + o); }
            if (MODE == EM_GLU && bj == 0) p.a[0] = *(const u32x4*)((const bf16_t*)(ws + WS_ZS) + (size_t)row * 512 + u.pn * 128 + wc * 32 + fq * 8);
        }
    }
    __device__ __forceinline__ float compute(const Pre& p, f32x4 (&acc)[2][2][4][2], const f32x4 (&cv)[2][2], const pg8::Unit& u, int ai, int m, int wr, int wc, int fr, int fq) const {
        const int row = u.pm * 256 + ai * 128 + wr * 64 + m * 16 + fr;
        float ssq = 0.f;
        float rs = 1.f;
        u32x4 pk[2]; pk[0] = (u32x4){0u, 0u, 0u, 0u}; pk[1] = pk[0];
        const size_t trow = (size_t)(u.pm * 256 + ai * 128 + wr * 64 + m * 16);
        if (MODE == EM_PROJ || MODE == EM_GATES) rs = p.rs;
        if (MODE == EM_RES2) rs = rsqrtf(p.rs * (1.0f / 1024.0f) + EPS);
#pragma unroll
        for (int bj = 0; bj < 2; ++bj) {
            if ((MODE == EM_GLU || MODE == EM_S5A) && bj == 1) continue;
            const int ct = bj * 128 + wc * 32 + fq * 8;
            float v[8];
#pragma unroll
            for (int j = 0; j < 4; ++j) { v[j] = acc[ai][bj][m][0][j]; v[4 + j] = acc[ai][bj][m][1][j]; }
            if (MODE == EM_PROJ) {
                const int pn = u.pn;
                if (pn < 16) {
                    const int sec = pn >> 2, col = (pn & 3) * 256 + ct; const size_t o = (size_t)row * 1024 + col;
                    if (sec == 0) { float w[8];
#pragma unroll
                        for (int j = 0; j < 8; ++j) w[j] = v[j] * rs;
                        __builtin_nontemporal_store(pack8(w), (u32x4*)((bf16_t*)(ws + WS_Q) + o));
                    } else if (sec == 1) {
                        float lf[8];
#pragma unroll
                        for (int j = 0; j < 8; ++j) { const float lb = j < 4 ? cv[bj][0][j] : cv[bj][1][j - 4]; const float sg = sigmoidf_(v[j] * rs); lf[j] = __logf(lb + (1.f - lb) * sg); }
                        u32x4 hw; hw.x = pkh2(lf[0], lf[1]); hw.y = pkh2(lf[2], lf[3]); hw.z = pkh2(lf[4], lf[5]); hw.w = pkh2(lf[6], lf[7]);
                        __builtin_nontemporal_store(hw, (u32x4*)((_Float16*)out + o));
                    } else if (sec == 2) { float w[8];
#pragma unroll
                        for (int j = 0; j < 8; ++j) w[j] = v[j] * rs;
                        __builtin_nontemporal_store(pack8(w), (u32x4*)((bf16_t*)(ws + WS_IV) + o));
                    } else { float w[8];
#pragma unroll
                        for (int j = 0; j < 8; ++j) { const float z = v[j] * rs; w[j] = z * sigmoidf_(z); }
                        __builtin_nontemporal_store(pack8(w), (u32x4*)((bf16_t*)(ws + WS_GH) + o));
                    }
                } else if (pn < 18) {
                    const int col5 = (pn - 16) * 256 + ct, g = col5 >> 4, c = col5 & 15; float w[8];
#pragma unroll
                    for (int j = 0; j < 8; ++j) w[j] = v[j] * rs;
                    *(u32x4*)((bf16_t*)(ws + WS_A5) + ((size_t)(g * 2048 + (row >> 4)) * 384 + (row & 15) * 16 + c)) = pack8(w);
                } else {
                    const int col = (pn - 18) * 256 + ct; float w[8];
#pragma unroll
                    for (int j = 0; j < 8; ++j) { const float z = v[j] * rs; w[j] = z * sigmoidf_(z); }
                    __builtin_nontemporal_store(pack8(w), (u32x4*)((bf16_t*)(ws + WS_ZS) + (size_t)row * 512 + col));
                }
            } else if (MODE == EM_GATES) {
                const int col = u.pn * 256 + ct; float w[8];
#pragma unroll
                for (int j = 0; j < 8; ++j) w[j] = sigmoidf_(v[j] * rs) * 255.0f + 0.5f;
                u32x2 cd; cd.x = (unsigned)w[0] | ((unsigned)w[1] << 8) | ((unsigned)w[2] << 16) | ((unsigned)w[3] << 24); cd.y = (unsigned)w[4] | ((unsigned)w[5] << 8) | ((unsigned)w[6] << 16) | ((unsigned)w[7] << 24);
                *(u32x2*)(ws + WS_G8 + (size_t)row * 2048 + col) = cd;
            } else if (MODE == EM_PLAIN) {
                pk[bj] = pack8(v);
            } else if (MODE == EM_GLU) {
                const int col = u.pn * 128 + wc * 32 + fq * 8;
                float zs[8]; unpack8(p.a[0], zs);
                float w[8];
#pragma unroll
                for (int j = 0; j < 8; ++j) { const float a = v[j] + (j < 4 ? cv[0][0][j] : cv[0][1][j - 4]); const float b = (j < 4 ? acc[ai][1][m][0][j] : acc[ai][1][m][1][j - 4]) + (j < 4 ? cv[1][0][j] : cv[1][1][j - 4]); w[j] = a * sigmoidf_(b) * zs[j]; }
                *(u32x4*)((bf16_t*)(ws + WS_YS2) + (size_t)row * 512 + col) = pack8(w);
            } else if (MODE == EM_MERGE) {
                const size_t o = (size_t)row * 1024 + u.pn * 256 + ct;
                float b[8]; unpack8(p.b[bj], b);
                float w[8];
#pragma unroll
                for (int j = 0; j < 8; ++j) { const unsigned wa = j < 4 ? p.a[bj].x : p.a[bj].y, wc2 = j < 4 ? p.a[bj].z : p.a[bj].w; const int sh = 8 * (j & 3);
                    const float ga = (float)((wa >> sh) & 255u) * (1.0f / 255.0f), gc = (float)((wc2 >> sh) & 255u) * (1.0f / 255.0f); w[j] = ga * b[j] + gc * v[j]; }
                pk[bj] = pack8(w); (void)o;
            } else if (MODE == EM_RES1) {
                const size_t o = (size_t)row * 1024 + u.pn * 256 + ct;
                float w[8], xr[8]; unpack8(p.a[bj], xr);
#pragma unroll
                for (int j = 0; j < 8; ++j) { w[j] = v[j] + xr[j]; ssq += w[j] * w[j]; }
                pk[bj] = pack8(w); (void)o;
            } else if (MODE == EM_RES2) {
                const size_t o = (size_t)row * 1024 + u.pn * 256 + ct;
                float pe[8], h1[8]; unpack8(p.a[bj], pe); unpack8(p.b[bj], h1);
                float w[8];
#pragma unroll
                for (int j = 0; j < 8; ++j) { w[j] = h1[j] + pe[j] * sigmoidf_(v[j] * rs); ssq += w[j] * w[j]; }
                acc[ai][bj][m][0] = (f32x4){w[0], w[1], w[2], w[3]}; acc[ai][bj][m][1] = (f32x4){w[4], w[5], w[6], w[7]};
                (void)o;
            } else if (MODE == EM_S5A) {
                float* e = (float*)(ws + WS_E) + (size_t)row * 128 + ct;
                *(f32x4*)e = (f32x4){v[0], v[1], v[2], v[3]}; *(f32x4*)(e + 4) = (f32x4){v[4], v[5], v[6], v[7]};
            } else if (MODE == EM_S5C) {
                const int g = u.pn, cr = row - g * 2048; const int tok = cr * 16 + (ct >> 4);
                float w[8];
#pragma unroll
                for (int j = 0; j < 8; ++j) w[j] = gelu_tanh(v[j]);
                *(u32x4*)((bf16_t*)(ws + WS_YSA) + (size_t)tok * 512 + g * 16 + (ct & 15)) = pack8(w);
            }
        }
        if (MODE == EM_PLAIN) stage512(pk[0], pk[1], (unsigned char*)O + (trow * ldc + u.pn * 256) * 2, (size_t)ldc * 2, wr, wc, fr, fq);
        if (MODE == EM_MERGE) stage512(pk[0], pk[1], ws + WS_MRG + (trow * 1024 + u.pn * 256) * 2, 2048, wr, wc, fr, fq);
        if (MODE == EM_RES1) stage512(pk[0], pk[1], ws + WS_H1B + (trow * 1024 + u.pn * 256) * 2, 2048, wr, wc, fr, fq);
        if (MODE == EM_RES1 || MODE == EM_RES2) { ssq += __shfl_xor(ssq, 16); ssq += __shfl_xor(ssq, 32); }
        return ssq;
    }
    __device__ __forceinline__ void operator()(f32x4 (&acc)[2][2][4][2], const pg8::Unit& u, int wr, int wc, int fr, int fq) const {
        f32x4 cv[2][2];
#pragma unroll
        for (int bj = 0; bj < 2; ++bj)
#pragma unroll
            for (int q = 0; q < 2; ++q) cv[bj][q] = (f32x4){0.f, 0.f, 0.f, 0.f};
        if (MODE == EM_PROJ) { if ((u.pn >> 2) == 1) {
#pragma unroll
            for (int bj = 0; bj < 2; ++bj) { const float* lb = (const float*)(ws + WS_LB) + (u.pn & 3) * 256 + bj * 128 + wc * 32 + fq * 8; cv[bj][0] = *(const f32x4*)lb; cv[bj][1] = *(const f32x4*)(lb + 4); } } }
        if (MODE == EM_GLU) { const int col = u.pn * 128 + wc * 32 + fq * 8;
            cv[0][0] = *(const f32x4*)(bglu + col); cv[0][1] = *(const f32x4*)(bglu + col + 4); cv[1][0] = *(const f32x4*)(bglu + 512 + col); cv[1][1] = *(const f32x4*)(bglu + 512 + col + 4); }
        if (MODE == EM_RES2) {
#pragma unroll
            for (int bj = 0; bj < 2; ++bj) { const float* fg = x + u.pn * 256 + bj * 128 + wc * 32 + fq * 8; cv[bj][0] = *(const f32x4*)fg; cv[bj][1] = *(const f32x4*)(fg + 4); } }
        constexpr int NB = (MODE == EM_RES1 || MODE == EM_MERGE) ? 4 : (MODE == EM_RES2 ? 2 : 8);
        float ssqv[8];
#pragma unroll
        for (int b0 = 0; b0 < 8; b0 += NB) {
            Pre pb[NB];
#pragma unroll
            for (int k = 0; k < NB; ++k) load(pb[k], u, (b0 + k) >> 2, (b0 + k) & 3, wr, wc, fr, fq);
#pragma unroll
            for (int k = 0; k < NB; ++k) ssqv[b0 + k] = compute(pb[k], acc, cv, u, (b0 + k) >> 2, (b0 + k) & 3, wr, wc, fr, fq);
        }
        if (MODE == EM_RES1 || MODE == EM_RES2) {
#pragma unroll
            for (int it = 0; it < 8; ++it) { const int row = u.pm * 256 + (it >> 2) * 128 + wr * 64 + (it & 3) * 16 + fr;
                if (fq == 0 && ldc == 0) atomicAdd((float*)(ws + (MODE == EM_RES1 ? WS_SS1 : WS_SS2)) + row, ssqv[it]); }
        }
        if (MODE == EM_RES2) {
            asm volatile("s_waitcnt vmcnt(0)" ::: "memory");
            __syncthreads();
            unsigned* cnt = (unsigned*)(ws + WS_CTL + 16384) + u.pm * 16;
            if (wr == 0 && wc == 0 && fr == 0 && fq == 0 && ldc == 0) {
                __hip_atomic_fetch_add(cnt, 1u, __ATOMIC_RELAXED, __HIP_MEMORY_SCOPE_AGENT);
                unsigned sp = 0;
                while (__hip_atomic_load(cnt, __ATOMIC_RELAXED, __HIP_MEMORY_SCOPE_AGENT) < 4u) { __builtin_amdgcn_s_sleep(1); if (++sp > (1u << 24)) break; }
                asm volatile("s_waitcnt vmcnt(0)" ::: "memory");
            }
            __syncthreads();
            float ssr[8];
#pragma unroll
            for (int k = 0; k < 8; ++k) ssr[k] = __hip_atomic_load((float*)(ws + WS_SS2) + (u.pm * 256 + (k >> 2) * 128 + wr * 64 + (k & 3) * 16 + fr), __ATOMIC_RELAXED, __HIP_MEMORY_SCOPE_AGENT);
#pragma unroll
            for (int ai = 0; ai < 2; ++ai)
#pragma unroll
                for (int m = 0; m < 4; ++m) {
                    const int row = u.pm * 256 + ai * 128 + wr * 64 + m * 16 + fr;
                    const float ss = ssr[ai * 4 + m];
                    const float r2 = rsqrtf(ss * (1.0f / 1024.0f) + EPS);
#pragma unroll
                    for (int bj = 0; bj < 2; ++bj) { float* o = out + (size_t)row * 1024 + u.pn * 256 + bj * 128 + wc * 32 + fq * 8;
                        *(f32x4*)o = acc[ai][bj][m][0] * r2 * cv[bj][0]; *(f32x4*)(o + 4) = acc[ai][bj][m][1] * r2 * cv[bj][1]; }
                }
        }
    }
};

__device__ __forceinline__ void s5_ktab_item(const struct Prm& P, LAS float* scr, int item, int lane);
__device__ __forceinline__ void s5_emat_item(const struct Prm& P, int item, int lane);
__device__ __forceinline__ void s5_tcarry_item(const struct Prm& P, int item, int lane);
__device__ __forceinline__ int glu_dest(int n) { return n < 512 ? ((n >> 7) * 256 + (n & 127)) : ((((n - 512) >> 7) * 256) + 128 + ((n - 512) & 127)); }
__device__ __forceinline__ void transpose_item(const float* W, int K, int N, bf16_t* WT, const float* kscale, bool glu, LAS float* scr, int item, int lane) {
    const int nblk = N / 32, kb = item / nblk, nb = item % nblk, k0 = 64 * kb, n0 = 32 * nb;
#pragma unroll 8
    for (int i = 0; i < 32; ++i) { const int kk = 2 * i + (lane >> 5); const float sc = kscale ? kscale[k0 + kk] : 1.f; scr[kk * 33 + (lane & 31)] = W[(size_t)(k0 + kk) * N + n0 + (lane & 31)] * sc; }
    asm volatile("s_waitcnt lgkmcnt(0)" ::: "memory");
    const int c = lane & 7;
#pragma unroll
    for (int j = 0; j < 4; ++j) { const int n = (lane >> 3) + 8 * j; const LAS float* s = scr + (8 * c) * 33 + n;
        u32x4 o; o.x = pk2(s[0 * 33], s[1 * 33]); o.y = pk2(s[2 * 33], s[3 * 33]); o.z = pk2(s[4 * 33], s[5 * 33]); o.w = pk2(s[6 * 33], s[7 * 33]);
        const int dn = glu ? glu_dest(n0 + n) : (n0 + n);
        *(u32x4*)(WT + (size_t)dn * K + k0 + 8 * c) = o; }
    asm volatile("s_waitcnt lgkmcnt(0)" ::: "memory");
}

__device__ __forceinline__ void p0_prologue(const Prm& P, LAS unsigned char* lds, int gw, int NGW, int wave, int lane) {
    unsigned char* ws = P.ws;
    LAS float* scr = (LAS float*)(lds + wave * 16384);
    constexpr int I_IN = 16 * 224, I_SQ = 16 * 32, I_GLU = 8 * 32, I_OS5 = 8 * 32, I_PLE = 4 * 32;
    constexpr int NITEMS = I_IN + I_SQ + I_GLU + I_OS5 + I_SQ + I_PLE + I_SQ;
    for (int it = gw; it < NITEMS; it += NGW) {
        int r = it;
        if (r < I_IN) { transpose_item(P.in[I_WIN], 1024, 7168, (bf16_t*)(ws + WS_WIN), P.in[I_NORMG], false, scr, r, lane); continue; } r -= I_IN;
        if (r < I_SQ) { transpose_item(P.in[I_WOHG], 1024, 1024, (bf16_t*)(ws + WS_WOHG), nullptr, false, scr, r, lane); continue; } r -= I_SQ;
        if (r < I_GLU) { transpose_item(P.in[I_WGLU], 512, 1024, (bf16_t*)(ws + WS_WGLU), nullptr, true, scr, r, lane); continue; } r -= I_GLU;
        if (r < I_OS5) { transpose_item(P.in[I_WOS5], 512, 1024, (bf16_t*)(ws + WS_WOS5), nullptr, false, scr, r, lane); continue; } r -= I_OS5;
        if (r < I_SQ) { transpose_item(P.in[I_WOUT], 1024, 1024, (bf16_t*)(ws + WS_WOUT), nullptr, false, scr, r, lane); continue; } r -= I_SQ;
        if (r < I_PLE) { transpose_item(P.in[I_WPLE], 256, 1024, (bf16_t*)(ws + WS_WPLE), nullptr, false, scr, r, lane); continue; } r -= I_PLE;
        transpose_item(P.in[I_WPG], 1024, 1024, (bf16_t*)(ws + WS_WPG), P.in[I_PLENG], false, scr, r, lane);
    }
    const float* x = P.in[I_X]; const float* p = P.in[I_P];
#define P0_LOAD(V, PV, M0) do { _Pragma("unroll") for (int r = 0; r < 2; ++r) { const f32x4* xr = (const f32x4*)(x + (size_t)((M0) + r) * 1024) + lane; \
            _Pragma("unroll") for (int j = 0; j < 4; ++j) V[r][j] = __builtin_nontemporal_load(xr + 64 * j); \
            PV[r] = __builtin_nontemporal_load((const f32x4*)(p + (size_t)((M0) + r) * 256) + lane); } } while (0)
#define P0_PROC(V, PV, M0) do { _Pragma("unroll") for (int r = 0; r < 2; ++r) { const int m = (M0) + r; float s = 0.f; \
            _Pragma("unroll") for (int j = 0; j < 4; ++j) s += (V[r][j].x * V[r][j].x + V[r][j].y * V[r][j].y) + (V[r][j].z * V[r][j].z + V[r][j].w * V[r][j].w); \
            s = wave_sum(s); \
            u32x2* o8 = (u32x2*)((bf16_t*)(ws + WS_XB) + (size_t)m * 1024) + lane; \
            _Pragma("unroll") for (int j = 0; j < 4; ++j) { u32x2 w; w.x = pk2(V[r][j].x, V[r][j].y); w.y = pk2(V[r][j].z, V[r][j].w); o8[64 * j] = w; } \
            u32x2 w; w.x = pk2(PV[r].x, PV[r].y); w.y = pk2(PV[r].z, PV[r].w); *((u32x2*)((bf16_t*)(ws + WS_PB) + (size_t)m * 256) + lane) = w; \
            if (lane == 0) { ((float*)(ws + WS_RINV0))[m] = rsqrtf(s * (1.0f / 1024.0f) + EPS); ((float*)(ws + WS_SS1))[m] = 0.f; ((float*)(ws + WS_SS2))[m] = 0.f; } } } while (0)
    {
        f32x4 va[2][4], vb[2][4]; f32x4 pa[2], pb2[2];
        const int step = NGW * 2; int m0 = gw * 2;
        if (m0 < MROWS) P0_LOAD(va, pa, m0);
        while (m0 < MROWS) {
            const int m1 = m0 + step;
            if (m1 < MROWS) P0_LOAD(vb, pb2, m1);
            P0_PROC(va, pa, m0);
            if (m1 >= MROWS) break;
            const int m2 = m1 + step;
            if (m2 < MROWS) P0_LOAD(va, pa, m2);
            P0_PROC(vb, pb2, m1);
            m0 = m2;
        }
    }
#undef P0_LOAD
#undef P0_PROC
    for (int it = gw; it < 512; it += NGW) s5_ktab_item(P, scr, it, lane);
    for (int it = gw; it < 8192; it += NGW) { s5_emat_item(P, it, lane); s5_tcarry_item(P, it, lane); }
    const int gt = gw * 64 + lane;
    if (gt < 1024) { const float a0 = P.in[I_HGLB][gt], a1 = P.in[I_HGLB][1024 + gt]; ((float*)(ws + WS_LB))[gt] = 1.0f / (1.0f + __expf(a1 - a0)); }
}

__device__ __forceinline__ void lam_pow(float ar, float ai, float dt, float d, float& pr, float& pi) { const float m = __expf(d * ar * dt); float s, c; sincosf(d * ai * dt, &s, &c); pr = m * c; pi = m * s; }
__device__ __forceinline__ void zoh_scale(float ar, float ai, float dt, float& sr, float& si) {
    const float th = ai * dt; float s, c; sincosf(th, &s, &c); const float m = __expf(ar * dt); const float sh = sinf(0.5f * th);
    const float nr = expm1f(ar * dt) * c - 2.0f * sh * sh, li = m * s; const float den = ar * ar + ai * ai;
    sr = (nr * ar + li * ai) / den; si = (li * ar - nr * ai) / den;
}
__device__ __forceinline__ void s5_ktab_item(const Prm& P, LAS float* scr, int item, int lane) {
    const int g = item >> 4, d = item & 15, n = lane;
    const float dt = __expf(P.in[I_LOGDT][g]); const float ar = P.in[I_ARE][g * 64 + n], ai = P.in[I_AIM][g * 64 + n];
    float pr, pi; lam_pow(ar, ai, dt, (float)d, pr, pi); float sr, si; zoh_scale(ar, ai, dt, sr, si);
    const float qr = pr * sr - pi * si, qi = pr * si + pi * sr;
#pragma unroll
    for (int c = 0; c < 16; ++c) { const float br = P.in[I_BRE][(g * 64 + n) * 16 + c], bi = P.in[I_BIM][(g * 64 + n) * 16 + c]; scr[n * 33 + c] = qr * br - qi * bi; scr[n * 33 + 16 + c] = qr * bi + qi * br; }
    asm volatile("s_waitcnt lgkmcnt(0)" ::: "memory");
    const int cp = lane >> 2, c0 = (lane & 3) * 4; float o[4] = {0.f, 0.f, 0.f, 0.f};
    const float* cre = P.in[I_CRE] + (g * 16 + cp) * 64; const float* cim = P.in[I_CIM] + (g * 16 + cp) * 64;
    for (int nn = 0; nn < 64; ++nn) { const float cr = cre[nn], ci = cim[nn];
#pragma unroll
        for (int j = 0; j < 4; ++j) o[j] += cr * scr[nn * 33 + c0 + j] - ci * scr[nn * 33 + 16 + c0 + j]; }
    if (d == 0) {
#pragma unroll
        for (int j = 0; j < 4; ++j) if (c0 + j == cp) o[j] += P.in[I_D][g * 16 + cp]; }
    *(f32x4*)((float*)(P.ws + WS_KTAB) + ((size_t)(g * 16 + d) * 16 + cp) * 16 + c0) = (f32x4){o[0], o[1], o[2], o[3]};
    asm volatile("s_waitcnt lgkmcnt(0)" ::: "memory");
}
__device__ __forceinline__ void s5_emat_item(const Prm& P, int item, int lane) {
    const int g = item >> 8, n2 = item & 255; u32x2 w; w.x = 0u; w.y = 0u;
    if (n2 < 128) {
        const int n = n2 & 63, part = n2 >> 6, s = lane >> 2, c0 = (lane & 3) * 4;
        const float dt = __expf(P.in[I_LOGDT][g]); const float ar = P.in[I_ARE][g * 64 + n], ai = P.in[I_AIM][g * 64 + n];
        float pr, pi; lam_pow(ar, ai, dt, (float)(15 - s), pr, pi); float sr, si; zoh_scale(ar, ai, dt, sr, si);
        const float qr = pr * sr - pi * si, qi = pr * si + pi * sr; float o[4];
#pragma unroll
        for (int j = 0; j < 4; ++j) { const float br = P.in[I_BRE][(g * 64 + n) * 16 + c0 + j], bi = P.in[I_BIM][(g * 64 + n) * 16 + c0 + j]; o[j] = part ? (qr * bi + qi * br) : (qr * br - qi * bi); }
        w.x = pk2(o[0], o[1]); w.y = pk2(o[2], o[3]);
    }
    *((u32x2*)((bf16_t*)(P.ws + WS_EMAT) + (size_t)item * 256) + lane) = w;
}
__device__ __forceinline__ void s5_tcarry_item(const Prm& P, int item, int lane) {
    const int g = item >> 8, t = (item >> 4) & 15, cp = item & 15; const float dt = __expf(P.in[I_LOGDT][g]); float o[2];
#pragma unroll
    for (int j = 0; j < 2; ++j) { const int n2 = lane * 2 + j, n = n2 & 63, part = n2 >> 6;
        const float ar = P.in[I_ARE][g * 64 + n], ai = P.in[I_AIM][g * 64 + n]; float pr, pi; lam_pow(ar, ai, dt, (float)(t + 1), pr, pi);
        const float cr = P.in[I_CRE][(g * 16 + cp) * 64 + n], ci = P.in[I_CIM][(g * 16 + cp) * 64 + n];
        o[j] = part ? -(cr * pi + ci * pr) : (cr * pr - ci * pi); }
    *((unsigned*)((bf16_t*)(P.ws + WS_TCAT) + (size_t)item * 384 + 256) + lane) = pk2(o[0], o[1]);
}
__device__ __forceinline__ void s5_toeplitz_item(const Prm& P, int item, int lane) {
    const int g = item >> 8, t = (item >> 4) & 15, cp = item & 15, s = lane >> 2, c0 = (lane & 3) * 4; u32x2 w; w.x = 0u; w.y = 0u;
    if (s <= t) { const f32x4 k = *(const f32x4*)((const float*)(P.ws + WS_KTAB) + ((size_t)(g * 16 + (t - s)) * 16 + cp) * 16 + c0); w.x = pk2(k[0], k[1]); w.y = pk2(k[2], k[3]); }
    *((u32x2*)((bf16_t*)(P.ws + WS_TCAT) + (size_t)item * 384) + lane) = w;
}
__device__ __forceinline__ void s5_scan(const Prm& P, LAS unsigned char* lds, int item, int wave) {
    const int lane = lane_id(), tid = wave * 64 + lane, nl = tid & 31, ss = tid >> 5, b = item >> 6, g = (item >> 1) & 31, half = item & 1, n = half * 32 + nl;
    const float dt = __expf(P.in[I_LOGDT][g]); const float ar = P.in[I_ARE][g * 64 + n], ai = P.in[I_AIM][g * 64 + n];
    float Lr, Li; lam_pow(ar, ai, dt, 16.0f, Lr, Li);
    float L8r = Lr, L8i = Li;
#pragma unroll
    for (int q = 0; q < 3; ++q) { const float a = L8r * L8r - L8i * L8i, c = 2.0f * L8r * L8i; L8r = a; L8i = c; }
    LAS float* tile = (LAS float*)lds; LAS float* agg = tile + 128 * 64;
    const float* E = (const float*)(P.ws + WS_E); bf16_t* A5 = (bf16_t*)(P.ws + WS_A5);
    float car = 0.f, cai = 0.f;
    f32x4 ev[4];
#define S5_ELOAD(PIECE) do { const size_t rb_ = (size_t)g * 2048 + b * 512 + (PIECE) * 128; _Pragma("unroll") for (int i = 0; i < 4; ++i) { const int idx = tid + i * 512, r = idx >> 4, part = (idx >> 3) & 1, c4 = idx & 7; \
            ev[i] = *(const f32x4*)(E + (rb_ + r) * 128 + part * 64 + half * 32 + c4 * 4); } } while (0)
    S5_ELOAD(0);
    for (int piece = 0; piece < 4; ++piece) {
        const size_t rowbase = (size_t)g * 2048 + b * 512 + piece * 128;
#pragma unroll
        for (int i = 0; i < 4; ++i) { const int idx = tid + i * 512, r = idx >> 4, part = (idx >> 3) & 1, c4 = idx & 7;
            *(LAS f32x4*)(tile + r * 64 + part * 32 + c4 * 4) = ev[i]; }
        if (piece + 1 < 4) S5_ELOAD(piece + 1);
        __syncthreads();
        const int r0 = ss * 8; float xr[8], xi[8]; float pr = 0.f, pi = 0.f;
#pragma unroll
        for (int j = 0; j < 8; ++j) { xr[j] = pr; xi[j] = pi; const float er = tile[(r0 + j) * 64 + nl], ei = tile[(r0 + j) * 64 + 32 + nl];
            const float a = Lr * pr - Li * pi + er, c = Lr * pi + Li * pr + ei; pr = a; pi = c; }
        agg[ss * 64 + nl] = pr; agg[ss * 64 + 32 + nl] = pi;
        __syncthreads();
        float cr = car, ci = cai, mr = 0.f, mi = 0.f;
#pragma unroll
        for (int s2 = 0; s2 < 16; ++s2) { if (s2 == ss) { mr = cr; mi = ci; } const float a = L8r * cr - L8i * ci + agg[s2 * 64 + nl], c = L8r * ci + L8i * cr + agg[s2 * 64 + 32 + nl]; cr = a; ci = c; }
        car = cr; cai = ci;
        float pwr = 1.f, pwi = 0.f;
#pragma unroll
        for (int j = 0; j < 8; ++j) { const float hr = xr[j] + pwr * mr - pwi * mi, hi = xi[j] + pwr * mi + pwi * mr;
            bf16_t* dst = A5 + (rowbase + r0 + j) * 384 + 256 + n; dst[0] = (bf16_t)f2bf(hr); dst[64] = (bf16_t)f2bf(hi);
            const float a = pwr * Lr - pwi * Li, c = pwr * Li + pwi * Lr; pwr = a; pwi = c; }
        __syncthreads();
    }
#undef S5_ELOAD
}

typedef float f32x16 __attribute__((ext_vector_type(16)));
constexpr int HL_QM = 0, HL_KM = 17408, HL_OS = 0, HL_QD = 34816, HL_KDT = 52224, HL_IVT = 70656, HL_ST = 89088, HL_PP = 123904, HL_TOT = 133120, HL_DC = 137216;
template <bool FULL, bool STORE = true>
__device__ __forceinline__ void hg_item(const Prm& P, LAS unsigned char* lds, int item, int wave) {
    unsigned char* ws = P.ws; const int lane = lane_id(), tid = wave * 64 + lane;
    const int b = item >> 6, h = (item >> 3) & 7, seg = item & 7;
    const int l31 = lane & 31, lh = lane >> 5;
    const int k2 = lane * 2, tg = wave;
    const int kb = wave >> 1, vb0 = (wave & 1) * 2;
    const _Float16* LF = (const _Float16*)P.out; const bf16_t* Q = (const bf16_t*)(ws + WS_Q); const bf16_t* IV = (const bf16_t*)(ws + WS_IV); const bf16_t* GH = (const bf16_t*)(ws + WS_GH);
    bf16_t* AHG = (bf16_t*)(ws + WS_AHG);
    float* AGG = (float*)(ws + WS_HGAGG); float* DEC = (float*)(ws + WS_HGDEC);
    f32x16 S[2];
#pragma unroll
    for (int i = 0; i < 2; ++i)
#pragma unroll
        for (int r = 0; r < 16; ++r) S[i][r] = 0.f;
    float sumlog0 = 0.f, sumlog1 = 0.f;
    if (FULL) {
        for (int s2 = 0; s2 < seg; ++s2) { const int it2 = item - seg + s2;
#pragma unroll
            for (int g4 = 0; g4 < 4; ++g4) { const f32x4 d = *(const f32x4*)(DEC + it2 * 128 + kb * 32 + 8 * g4 + 4 * lh);
#pragma unroll
                for (int i = 0; i < 2; ++i)
#pragma unroll
                    for (int j = 0; j < 4; ++j) { const int r = 4 * g4 + j; S[i][r] = d[j] * S[i][r] + AGG[(size_t)((it2 * 8 + wave) * 2 + i) * 1024 + r * 64 + lane]; } } }
#pragma unroll
        for (int i = 0; i < 2; ++i)
#pragma unroll
            for (int g4 = 0; g4 < 4; ++g4) { u32x2 w; w.x = pk2(S[i][4 * g4], S[i][4 * g4 + 1]); w.y = pk2(S[i][4 * g4 + 2], S[i][4 * g4 + 3]);
                *(LAS u32x2*)(lds + HL_ST + ((vb0 + i) * 32 + l31) * 272 + (kb * 32 + 8 * g4 + 4 * lh) * 2) = w; }
        for (int e = tid; e < 32 * 16; e += NTHR) { const int t = e >> 4, c = e & 15; *(LAS unsigned*)(lds + HL_PP + t * 144 + 64 + c * 4) = 0u; }
    }
    float c0[8], c1[8]; unsigned qw[8], ivw[8]; u32x4 ghw0, ghw1;
#define HG_LOADS(CH) do { const size_t row0_ = (size_t)b * SEQ + seg * 1024 + (CH) * 64; _Pragma("unroll") for (int i = 0; i < 8; ++i) { const size_t o = (row0_ + tg * 8 + i) * 1024 + h * 128 + k2; \
            const unsigned lw_ = FULL ? __builtin_nontemporal_load((const unsigned*)(LF + o)) : *(const unsigned*)(LF + o); const f16x2 l = __builtin_bit_cast(f16x2, lw_); c0[i] = (float)l.x; c1[i] = (float)l.y; \
            ivw[i] = FULL ? __builtin_nontemporal_load((const unsigned*)(IV + o)) : *(const unsigned*)(IV + o); if (FULL) qw[i] = __builtin_nontemporal_load((const unsigned*)(Q + o)); } \
        if (FULL) { const size_t oo_ = (row0_ + (tid >> 3)) * 1024 + h * 128 + (tid & 7) * 16; ghw0 = __builtin_nontemporal_load((const u32x4*)(GH + oo_)); ghw1 = __builtin_nontemporal_load((const u32x4*)(GH + oo_ + 8)); } } while (0)
    HG_LOADS(0);
    for (int ch = 0; ch < 16; ++ch) {
        const size_t row0 = (size_t)b * SEQ + seg * 1024 + ch * 64;
        float ka[8], kc[8], f0[8], f1[8]; float t0 = 0.f, t1 = 0.f;
#pragma unroll
        for (int i = 0; i < 8; ++i) { f0[i] = __expf(c0[i]); f1[i] = __expf(c1[i]); ka[i] = 1.0f - f0[i]; kc[i] = 1.0f - f1[i]; t0 += c0[i]; t1 += c1[i]; }
        *(LAS f32x2*)(lds + HL_TOT + (tg * 128 + k2) * 4) = (f32x2){t0, t1};
        __syncthreads();
        float off0 = 0.f, off1 = 0.f, bm0 = 0.f, bm1 = 0.f, bl0 = 0.f, bl1 = 0.f;
#pragma unroll
        for (int g8 = 0; g8 < 8; ++g8) { const f32x2 t2 = *(const LAS f32x2*)(lds + HL_TOT + (g8 * 128 + k2) * 4); if (g8 < tg) { off0 += t2.x; off1 += t2.y; } if (g8 < 4) { bm0 += t2.x; bm1 += t2.y; } bl0 += t2.x; bl1 += t2.y; }
        {
            float kd0[8], kd1[8], iv0[8], iv1[8];
            float e0 = __expf(off0 + c0[0] - bm0), e1 = __expf(off1 + c1[0] - bm1);
            const float ebm0 = __expf(bm0), ebm1 = __expf(bm1), ebl0 = __expf(bl0 - bm0), ebl1 = __expf(bl1 - bm1);
#pragma unroll
            for (int i = 0; i < 8; ++i) { if (i) { e0 *= f0[i]; e1 *= f1[i]; }
                const float r0 = __builtin_amdgcn_rcpf(e0), r1 = __builtin_amdgcn_rcpf(e1);
                kd0[i] = ka[i] * r0 * ebl0; kd1[i] = kc[i] * r1 * ebl1; iv0[i] = bflo(ivw[i]); iv1[i] = bfhi(ivw[i]);
                if (FULL) { const float qa = bflo(qw[i]), qc = bfhi(qw[i]); const int t = tg * 8 + i;
                    *(LAS unsigned*)(lds + HL_QM + t * 272 + k2 * 2) = pk2(qa * e0, qc * e1);
                    *(LAS unsigned*)(lds + HL_KM + t * 272 + k2 * 2) = pk2(ka[i] * r0, kc[i] * r1);
                    *(LAS unsigned*)(lds + HL_QD + t * 272 + k2 * 2) = pk2(qa * e0 * ebm0, qc * e1 * ebm1); } }
            *(LAS u32x4*)(lds + HL_KDT + k2 * 144 + tg * 16) = pack8(kd0); *(LAS u32x4*)(lds + HL_KDT + (k2 + 1) * 144 + tg * 16) = pack8(kd1);
            *(LAS u32x4*)(lds + HL_IVT + k2 * 144 + tg * 16) = pack8(iv0); *(LAS u32x4*)(lds + HL_IVT + (k2 + 1) * 144 + tg * 16) = pack8(iv1);
            if (tg == 0) { *(LAS f32x2*)(lds + HL_DC + k2 * 4) = (f32x2){__expf(bl0), __expf(bl1)}; sumlog0 += bl0; sumlog1 += bl1; }
        }
        const u32x4 gcur0 = ghw0, gcur1 = ghw1;
        if (ch + 1 < 16) HG_LOADS(ch + 1);
        __syncthreads();
        if (FULL) {
            if (wave < 3) { const int tb = wave ? 1 : 0, sb = wave == 2 ? 1 : 0; f32x16 sc;
#pragma unroll
                for (int r = 0; r < 16; ++r) sc[r] = 0.f;
#pragma unroll
                for (int ks = 0; ks < 8; ++ks) { const bf16x8 a = *(const LAS bf16x8*)(lds + HL_QM + (tb * 32 + l31) * 272 + ks * 32 + lh * 16), bb = *(const LAS bf16x8*)(lds + HL_KM + (sb * 32 + l31) * 272 + ks * 32 + lh * 16);
                    sc = __builtin_amdgcn_mfma_f32_32x32x16_bf16(a, bb, sc, 0, 0, 0); }
#pragma unroll
                for (int r = 0; r < 16; ++r) { const int t = tb * 32 + (r & 3) + 8 * (r >> 2) + 4 * lh, s = sb * 32 + l31; *(LAS bf16_t*)(lds + HL_PP + t * 144 + s * 2) = (bf16_t)f2bf(s <= t ? sc[r] : 0.f); }
            }
            __syncthreads();
            { const int tb = wave >> 2, vb = wave & 3; f32x16 o;
#pragma unroll
                for (int r = 0; r < 16; ++r) o[r] = 0.f;
#pragma unroll
                for (int ks = 0; ks < 4; ++ks) { if (ks < 2 || tb) { const bf16x8 a = *(const LAS bf16x8*)(lds + HL_PP + (tb * 32 + l31) * 144 + ks * 32 + lh * 16), bb = *(const LAS bf16x8*)(lds + HL_IVT + (vb * 32 + l31) * 144 + ks * 32 + lh * 16);
                        o = __builtin_amdgcn_mfma_f32_32x32x16_bf16(a, bb, o, 0, 0, 0); } }
#pragma unroll
                for (int ks = 0; ks < 8; ++ks) { const bf16x8 a = *(const LAS bf16x8*)(lds + HL_QD + (tb * 32 + l31) * 272 + ks * 32 + lh * 16), bb = *(const LAS bf16x8*)(lds + HL_ST + (vb * 32 + l31) * 272 + ks * 32 + lh * 16);
                    o = __builtin_amdgcn_mfma_f32_32x32x16_bf16(a, bb, o, 0, 0, 0); }
#pragma unroll
                for (int r = 0; r < 16; ++r) { const int t = tb * 32 + (r & 3) + 8 * (r >> 2) + 4 * lh; *(LAS float*)(lds + HL_OS + t * 528 + (vb * 32 + l31) * 4) = o[r]; }
            }
        }
#pragma unroll
        for (int g4 = 0; g4 < 4; ++g4) { const f32x4 d = *(const LAS f32x4*)(lds + HL_DC + (kb * 32 + 8 * g4 + 4 * lh) * 4);
#pragma unroll
            for (int i = 0; i < 2; ++i)
#pragma unroll
                for (int j = 0; j < 4; ++j) S[i][4 * g4 + j] *= d[j]; }
#pragma unroll
        for (int ks = 0; ks < 4; ++ks) { const bf16x8 a = *(const LAS bf16x8*)(lds + HL_KDT + (kb * 32 + l31) * 144 + ks * 32 + lh * 16);
#pragma unroll
            for (int i = 0; i < 2; ++i) { const bf16x8 bb = *(const LAS bf16x8*)(lds + HL_IVT + ((vb0 + i) * 32 + l31) * 144 + ks * 32 + lh * 16); S[i] = __builtin_amdgcn_mfma_f32_32x32x16_bf16(a, bb, S[i], 0, 0, 0); } }
        if (FULL) {
            __syncthreads();
#pragma unroll
            for (int i = 0; i < 2; ++i)
#pragma unroll
                for (int g4 = 0; g4 < 4; ++g4) { u32x2 w; w.x = pk2(S[i][4 * g4], S[i][4 * g4 + 1]); w.y = pk2(S[i][4 * g4 + 2], S[i][4 * g4 + 3]);
                    *(LAS u32x2*)(lds + HL_ST + ((vb0 + i) * 32 + l31) * 272 + (kb * 32 + 8 * g4 + 4 * lh) * 2) = w; }
            { const int t = tid >> 3, vs = (tid & 7) * 16; float o[16]; float ss = 0.f;
#pragma unroll
                for (int q4 = 0; q4 < 4; ++q4) { const f32x4 x4 = *(const LAS f32x4*)(lds + HL_OS + t * 528 + (vs + 4 * q4) * 4);
#pragma unroll
                    for (int j = 0; j < 4; ++j) { o[4 * q4 + j] = x4[j]; ss += x4[j] * x4[j]; } }
                ss += __shfl_xor(ss, 1); ss += __shfl_xor(ss, 2); ss += __shfl_xor(ss, 4);
                const float r = rsqrtf(ss * (1.0f / 128.0f) + EPS);
                const size_t oo = (row0 + t) * 1024 + h * 128 + vs; const float* gn = P.in[I_HGNG] + h * 128 + vs;
                float g0[8], g1[8]; unpack8(gcur0, g0); unpack8(gcur1, g1);
                float w0[8], w1[8];
#pragma unroll
                for (int j = 0; j < 8; ++j) { w0[j] = o[j] * r * gn[j] * g0[j]; w1[j] = o[8 + j] * r * gn[8 + j] * g1[j]; }
                if (STORE) { *(u32x4*)(AHG + oo) = pack8(w0); *(u32x4*)(AHG + oo + 8) = pack8(w1); }
            }
        }
    }
#undef HG_LOADS
    if (!FULL) {
#pragma unroll
        for (int i = 0; i < 2; ++i)
#pragma unroll
            for (int r = 0; r < 16; ++r) AGG[(size_t)((item * 8 + wave) * 2 + i) * 1024 + r * 64 + lane] = S[i][r];
        if (tg == 0) *(f32x2*)(DEC + item * 128 + k2) = (f32x2){__expf(sumlog0), __expf(sumlog1)};
    }
    __syncthreads();
}


#define XB_TMO      128
#define XB_XCNT(j)  (256  + 64 * (j))
#define XB_XSUB(j)  (1280 + 64 * (j))
#define XB_XGEN(j)  (2304 + 64 * (j))
#define XB_TOP      3328
#define XB_TOPGEN   3392
#define XCD_BAR_WORDS 3456
#define XB_SPIN_CAP (1u << 22)
__device__ __forceinline__ unsigned xb_ld(unsigned* p)              { return __hip_atomic_load(p, __ATOMIC_RELAXED, __HIP_MEMORY_SCOPE_AGENT); }
__device__ __forceinline__ unsigned xb_add(unsigned* p, unsigned v) { return __hip_atomic_fetch_add(p, v, __ATOMIC_RELAXED, __HIP_MEMORY_SCOPE_AGENT); }
__device__ __forceinline__ unsigned xb_xcc_id() { return (unsigned)__builtin_amdgcn_s_getreg((3 << 11) | 20) & 0xFu; }
#define XB_SPIN(cond, bar) do { unsigned _sp = 0; while (cond) { __builtin_amdgcn_s_sleep(1); \
    if ((++_sp & 255u) == 0u) { if (xb_ld(&(bar)[XB_TMO])) break; if (_sp > XB_SPIN_CAP) { atomicAdd(&(bar)[XB_TMO], 1u); break; } } } } while (0)
struct XcdBarrier { unsigned* bar; unsigned x; volatile LAS unsigned* st; int wave; };
__device__ __forceinline__ XcdBarrier xcd_barrier_post(unsigned* bar, volatile LAS unsigned* st, int wave) {
    XcdBarrier b; b.bar = bar; b.x = xb_xcc_id(); b.st = st; b.wave = wave;
    if (wave == 0 && lane_id() == 0) (void)xb_add(&bar[XB_XCNT(b.x)], 1u);
    return b;
}
__device__ __forceinline__ void xcd_barrier_complete(unsigned* bar, unsigned x, unsigned& nloc, unsigned& nx) {
    const unsigned G = gridDim.x * gridDim.y * gridDim.z;
    unsigned sum, cnt, mine, sp = 0u;
    for (;;) {
        sum = 0u; cnt = 0u; mine = 0u;
#pragma unroll
        for (unsigned j = 0; j < 16; ++j) { const unsigned c = xb_ld(&bar[XB_XCNT(j)]); sum += c; cnt += (c > 0u) ? 1u : 0u; mine = (j == x) ? c : mine; }
        if (sum == G) break;
        __builtin_amdgcn_s_sleep(1);
        if ((++sp & 255u) == 0u) { if (xb_ld(&bar[XB_TMO])) break; if (sp > XB_SPIN_CAP) { atomicAdd(&bar[XB_TMO], 1u); break; } }
    }
    nloc = mine > 0u ? mine : 1u; nx = cnt > 0u ? cnt : 1u;
}
__device__ __forceinline__ void xcd_barrier(const XcdBarrier& b) {
    asm volatile("s_waitcnt vmcnt(0)" ::: "memory");
    __syncthreads();
    if (b.wave == 0 && lane_id() == 0) {
        unsigned* bar = b.bar;
        __builtin_amdgcn_s_waitcnt(0);
        unsigned nloc = b.st[0], nx = b.st[1];
        if (nloc == 0u) { xcd_barrier_complete(bar, b.x, nloc, nx); b.st[0] = nloc; b.st[1] = nx; }
        const unsigned old = xb_add(&bar[XB_XSUB(b.x)], 1u);
        const unsigned gen = old / nloc;
        if (old + 1u == (gen + 1u) * nloc) {
            __builtin_amdgcn_fence(__ATOMIC_RELEASE, "agent");
            asm volatile("s_waitcnt vmcnt(0)" ::: "memory");
            const unsigned og = xb_add(&bar[XB_TOP], 1u);
            const unsigned tg = og / nx;
            if (og + 1u == (tg + 1u) * nx) xb_add(&bar[XB_TOPGEN], 1u);
            else XB_SPIN(xb_ld(&bar[XB_TOPGEN]) == tg, bar);
            __builtin_amdgcn_fence(__ATOMIC_ACQUIRE, "agent");
            xb_add(&bar[XB_XGEN(b.x)], 1u);
            asm volatile("s_waitcnt vmcnt(0)" ::: "memory");
        } else {
            XB_SPIN(xb_ld(&bar[XB_XGEN(b.x)]) == gen, bar);
            __builtin_amdgcn_fence(__ATOMIC_ACQUIRE, "agent");
            asm volatile("s_waitcnt vmcnt(0)" ::: "memory");
        }
    }
    __syncthreads();
}

__global__ void __launch_bounds__(NTHR, 2) fwd_megakernel(Prm P) {
    extern __shared__ __attribute__((aligned(16))) unsigned char lds_raw[];
    LAS unsigned char* lds = (LAS unsigned char*)lds_raw;
    cg::grid_group grid = cg::this_grid();
    const int wave = __builtin_amdgcn_readfirstlane(threadIdx.x >> 6);
    if (P.coop == 2) grid.sync();
#define lane lane_id()
#define tid (wave * 64 + lane_id())
    const int G = gridDim.x, bx = blockIdx.x;
    const int gw = bx * NWAVES + wave, NGW = G * NWAVES;
    unsigned char* ws = P.ws;
    const int lo = P.ph_lo, hi = P.ph_hi;
#define IN(k) (lo <= (k) && (k) < hi)
    volatile LAS unsigned* bst = (volatile LAS unsigned*)(lds + LDS_MISC);
    if (tid < 16) bst[tid] = 0u;
    __syncthreads();
    XcdBarrier xbar = xcd_barrier_post((unsigned*)(ws + WS_CTL), bst, wave);
#define SEAM(k) do { if (IN(k) && IN((k) + 1)) xcd_barrier(xbar); } while (0)

    if (IN(0)) p0_prologue(P, lds, gw, NGW, wave, lane);
    SEAM(0);
    if (IN(1)) {
        { pg8::Gemm g{(const bf16_t*)(ws + WS_XB), (const bf16_t*)(ws + WS_WIN), 1024, 1024, 1024}; pg8::StaticOrder S; S.init(MROWS, NPROJ, G, bx);
          Epi<EM_PROJ> E{ws, nullptr, P.out, nullptr, nullptr, 0, lds}; pg8::gemm_phase(lds, g, S, E, wave); }
    }
    SEAM(1);
#define GATES_ROUNDS(R0, R1) do { pg8::Gemm g{(const bf16_t*)(ws + WS_XB), (const bf16_t*)(ws + WS_WIN) + (size_t)NPROJ * 1024, 1024, 1024, 1024}; pg8::RoundRange S; S.base.init(MROWS, 2048, G, bx); S.r0 = (R0); S.r1 = (R1); \
        Epi<EM_GATES> E{ws, nullptr, nullptr, nullptr, nullptr, 0, lds}; pg8::gemm_phase(lds, g, S, E, wave); } while (0)
    if (IN(2)) {
        if (bx & 1) GATES_ROUNDS(0, 2);
        for (int it = gw; it < 8192; it += NGW) s5_toeplitz_item(P, it, lane);
        { pg8::Gemm g{(const bf16_t*)(ws + WS_A5), (const bf16_t*)(ws + WS_EMAT), 384, 256, 256}; pg8::GroupOrder S{G, bx};
          Epi<EM_S5A> E{ws, nullptr, nullptr, nullptr, nullptr, 0, lds}; pg8::gemm_phase(lds, g, S, E, wave); }
        for (int it = bx; it < 256; it += G) hg_item<false>(P, lds, it, wave);
        if (!(bx & 1)) GATES_ROUNDS(0, 2);
    }
    SEAM(2);
    if (IN(3)) {
        if (!(bx & 1)) GATES_ROUNDS(2, 4);
        for (int it = bx; it < 256; it += G) s5_scan(P, lds, it, wave);
        for (int it = bx; it < 256; it += G) hg_item<true>(P, lds, it, wave);
        if (bx & 1) GATES_ROUNDS(2, 4);
    }
    SEAM(3);
    if (IN(4)) {
        { pg8::Gemm g{(const bf16_t*)(ws + WS_A5), (const bf16_t*)(ws + WS_TCAT), 384, 384, 384}; pg8::GroupOrder S{G, bx};
          Epi<EM_S5C> E{ws, nullptr, nullptr, nullptr, nullptr, 0, lds}; pg8::gemm_phase(lds, g, S, E, wave); }
        { pg8::Gemm g{(const bf16_t*)(ws + WS_AHG), (const bf16_t*)(ws + WS_WOHG), 1024, 1024, 1024}; pg8::StaticOrder S; S.init(MROWS, 1024, G, bx);
          Epi<EM_PLAIN> E{ws, nullptr, nullptr, nullptr, (bf16_t*)(ws + WS_YHG), 1024, lds}; pg8::gemm_phase(lds, g, S, E, wave); }
    }
    SEAM(4);
    if (IN(5)) {
        { pg8::Gemm g{(const bf16_t*)(ws + WS_YSA), (const bf16_t*)(ws + WS_WGLU), 512, 512, 512}; pg8::StaticOrder S; S.init(MROWS, 1024, G, bx);
          Epi<EM_GLU> E{ws, nullptr, nullptr, P.in[I_BGLU], nullptr, 0, lds}; pg8::gemm_phase(lds, g, S, E, wave); }
    }
    SEAM(5);
    if (IN(6)) {
        { pg8::Gemm g{(const bf16_t*)(ws + WS_YS2), (const bf16_t*)(ws + WS_WOS5), 512, 512, 512}; pg8::StaticOrder S; S.init(MROWS, 1024, G, bx);
          Epi<EM_MERGE> E{ws, nullptr, nullptr, nullptr, nullptr, 0, lds}; pg8::gemm_phase(lds, g, S, E, wave); }
    }
    SEAM(6);
    if (IN(7)) {
        { pg8::Gemm g{(const bf16_t*)(ws + WS_MRG), (const bf16_t*)(ws + WS_WOUT), 1024, 1024, 1024}; pg8::StaticOrder S; S.init(MROWS, 1024, G, bx);
          Epi<EM_RES1> E{ws, P.in[I_X], P.out, nullptr, nullptr, 0, lds}; pg8::gemm_phase(lds, g, S, E, wave); }
        { pg8::Gemm g{(const bf16_t*)(ws + WS_PB), (const bf16_t*)(ws + WS_WPLE), 256, 256, 256}; pg8::StaticOrder S; S.init(MROWS, 1024, G, bx);
          Epi<EM_PLAIN> E{ws, nullptr, nullptr, nullptr, (bf16_t*)(ws + WS_PE), 1024, lds}; pg8::gemm_phase(lds, g, S, E, wave); }
    }
    SEAM(7);
    if (IN(8)) {
        { pg8::Gemm g{(const bf16_t*)(ws + WS_H1B), (const bf16_t*)(ws + WS_WPG), 1024, 1024, 1024}; pg8::StaticOrder S; S.init(MROWS, 1024, G, bx);
          Epi<EM_RES2> E{ws, P.in[I_FNG], P.out, nullptr, nullptr, 0, lds}; pg8::gemm_phase(lds, g, S, E, wave); }
    }
    SEAM(8);
    if (IN(9)) {
        const float* fg = P.in[I_FNG];
        f32x4 gv[4];
#pragma unroll
        for (int j = 0; j < 4; ++j) gv[j] = *((const f32x4*)fg + lane + 64 * j);
        for (int m = gw; m < MROWS; m += NGW) {
            const float r = rsqrtf(((const float*)(ws + WS_SS2))[m] * (1.0f / 1024.0f) + EPS);
            f32x4* o = (f32x4*)(P.out + (size_t)m * 1024) + lane;
#pragma unroll
            for (int j = 0; j < 4; ++j) { f32x4 v = o[64 * j]; v = v * r * gv[j]; o[64 * j] = v; }
        }
    }
#undef IN
#undef SEAM
#undef lane
#undef tid
}

constexpr int LDS_BYTES = 149504;
constexpr int NPHASE = 9;
extern "C" void kernel_launch(void* const* d_in, const int* in_sizes, int n_in, void* d_out, int out_size, void* d_ws, size_t ws_size, hipStream_t stream) {
    static int grid = 0;
    if (grid == 0) {
        int dev = 0, cus = 0, per_cu = 0;
        hipGetDevice(&dev);
        hipDeviceGetAttribute(&cus, hipDeviceAttributeMultiprocessorCount, dev);
        hipFuncSetAttribute((const void*)fwd_megakernel, hipFuncAttributeMaxDynamicSharedMemorySize, LDS_BYTES);
        hipOccupancyMaxActiveBlocksPerMultiprocessor(&per_cu, (const void*)fwd_megakernel, NTHR, LDS_BYTES);
        if (per_cu < 1) per_cu = 1;
        grid = cus * 1;
        if (grid <= 0) grid = 256;
        if (ws_size < 504 * MiB) fprintf(stderr, "kernel_launch: workspace too small (%zu)\n", ws_size);
    }
    (void)hipMemsetAsync((char*)d_ws + WS_CTL, 0, 32768, stream);
    Prm p{};
    for (int i = 0; i < 23; ++i) p.in[i] = (const float*)d_in[i];
    p.out = (float*)d_out; p.ws = (unsigned char*)d_ws; p.ph_lo = 0; p.ph_hi = NPHASE; p.coop = 1; p.pad = 0;
    void* args[] = {&p};
    hipError_t e = hipLaunchCooperativeKernel((const void*)fwd_megakernel, dim3(grid), dim3(NTHR), args, LDS_BYTES, stream);
    if (e != hipSuccess) fprintf(stderr, "cooperative launch failed: %s (grid %d)\n", hipGetErrorString(e), grid);
}
```
